# Optimizing an MI355X kernel written in HIP

```python
import math
import jax, jax.numpy as jnp
from jax import lax
import numpy as np

D_MODEL = 2048
BATCH = 16
SEQ = 2048
DEPTH = 4

CHUNK = 64
Q_BLOCK = 128
N_EVEN = (DEPTH + 1) // 2
N_ODD = DEPTH // 2
EPS = 1e-6
ROPE_THETA = 10000.0
MAX_OFFSET = 4096

MLA_HEADS = 8
MLA_NOPE = 128
MLA_ROPE = 64
MLA_VDIM = 128
Q_LORA = 512
KV_LORA = 256
MLA_OUT = MLA_HEADS * MLA_VDIM

SGU_BLOCK = 128
SGU_GROUPS = 8
SGU_CH = 128
SGU_WIDTH = SGU_GROUPS * SGU_CH

EVEN_IN_WIDTH = Q_LORA + KV_LORA + MLA_ROPE + 2 * SGU_WIDTH
EVEN_SPLITS = (Q_LORA, Q_LORA + KV_LORA, Q_LORA + KV_LORA + MLA_ROPE,
               Q_LORA + KV_LORA + MLA_ROPE + SGU_WIDTH)
EVEN_OUT_WIDTH = MLA_OUT + SGU_WIDTH

RET_HEADS = 8
RET_DK = D_MODEL // RET_HEADS
RET_DV = 2 * RET_DK
RET_QK_WIDTH = RET_HEADS * RET_DK
RET_V_WIDTH = RET_HEADS * RET_DV
RET_IN_WIDTH = 2 * RET_QK_WIDTH + 2 * RET_V_WIDTH
RET_SPLITS = (RET_QK_WIDTH, 2 * RET_QK_WIDTH, 2 * RET_QK_WIDTH + RET_V_WIDTH)

D_FF = 5632
CONV_WIDTH = 3

PLE_DIM = 256

kernel_name = "hybrid_mla_gmlp_retention_convffn"


def _rms_norm(x, g):
    xf = x.astype(jnp.float32)
    y = xf * lax.rsqrt(jnp.mean(xf * xf, axis=-1, keepdims=True) + EPS)
    return (y * g.astype(jnp.float32)).astype(x.dtype)


def _layer_norm(x, g, b):
    xf = x.astype(jnp.float32)
    mu = jnp.mean(xf, axis=-1, keepdims=True)
    xc = xf - mu
    y = xc * lax.rsqrt(jnp.mean(xc * xc, axis=-1, keepdims=True) + EPS)
    return (y * g.astype(jnp.float32) + b.astype(jnp.float32)).astype(x.dtype)


def _rope(x, pos):
    half = x.shape[-1] // 2
    inv_freq = ROPE_THETA ** (-jnp.arange(half, dtype=jnp.float32) / half)
    ang = pos.astype(jnp.float32)[..., None] * inv_freq
    cos = jnp.cos(ang)[:, :, None, :]
    sin = jnp.sin(ang)[:, :, None, :]
    xf = x.astype(jnp.float32)
    x1, x2 = xf[..., :half], xf[..., half:]
    return jnp.concatenate([x1 * cos - x2 * sin, x2 * cos + x1 * sin], axis=-1).astype(x.dtype)


def _mla(c_q, c_kv, k_pe, pos, q_norm_g, w_q_up, kv_norm_g, w_kv_up):
    B, S, _ = c_q.shape
    q = (_rms_norm(c_q, q_norm_g) @ w_q_up).reshape(B, S, MLA_HEADS, MLA_NOPE + MLA_ROPE)
    q = jnp.concatenate([q[..., :MLA_NOPE], _rope(q[..., MLA_NOPE:], pos)], axis=-1)
    kv = (_rms_norm(c_kv, kv_norm_g) @ w_kv_up).reshape(B, S, MLA_HEADS, MLA_NOPE + MLA_VDIM)
    k_rot = _rope(k_pe[:, :, None, :], pos)
    k = jnp.concatenate([kv[..., :MLA_NOPE],
                         jnp.broadcast_to(k_rot, (B, S, MLA_HEADS, MLA_ROPE))], axis=-1)
    v = kv[..., MLA_NOPE:]
    scale = (MLA_NOPE + MLA_ROPE) ** -0.5
    n_qb = S // Q_BLOCK
    q_blocks = q.reshape(B, n_qb, Q_BLOCK, MLA_HEADS, MLA_NOPE + MLA_ROPE).swapaxes(0, 1)
    key_chunk = jnp.arange(S) // CHUNK

    def attend(args):
        qb, qi = args
        s = jnp.einsum('bqhd,bkhd->bhqk', qb, k, preferred_element_type=jnp.float32) * scale
        q_chunk = (qi * Q_BLOCK + jnp.arange(Q_BLOCK)) // CHUNK
        mask = key_chunk[None, :] <= q_chunk[:, None]
        s = jnp.where(mask, s, -jnp.inf)
        pr = jax.nn.softmax(s, axis=-1).astype(v.dtype)
        return jnp.einsum('bhqk,bkhd->bqhd', pr, v)

    o = lax.map(attend, (q_blocks, jnp.arange(n_qb)))
    return o.swapaxes(0, 1).reshape(B, S, MLA_OUT)


def _sgu(u, v, ln_g, ln_b, w_s, b_s):
    B, S, _ = u.shape
    u = jax.nn.gelu(u)
    v = _layer_norm(jax.nn.gelu(v), ln_g, ln_b)
    vr = v.reshape(B, S // SGU_BLOCK, SGU_BLOCK, SGU_GROUPS, SGU_CH)
    pos_chunk = jnp.arange(SGU_BLOCK) // CHUNK
    w = jnp.where(pos_chunk[:, None] >= pos_chunk[None, :], w_s, 0.0)
    s = jnp.einsum('gpq,bnqgc->bnpgc', w, vr) + b_s.T[None, None, :, :, None]
    return u * s.reshape(B, S, SGU_WIDTH)


def _retention(q, k, v, pos):
    B, S, H, _ = q.shape
    n = S // CHUNK
    q = _rope(q, pos)
    k = _rope(k, pos) * (RET_DK ** -0.5)
    log_g = jnp.log1p(-(2.0 ** (-5.0 - jnp.arange(H, dtype=jnp.float32))))
    idx = jnp.arange(CHUNK, dtype=jnp.float32)
    intra_decay = jnp.exp(log_g[:, None, None] * jnp.abs(idx[:, None] - idx[None, :]))
    k_decay = jnp.exp(log_g[None, :] * (CHUNK - 1 - idx)[:, None])
    q_decay = jnp.exp(log_g[None, :] * (idx + 1.0)[:, None])
    chunk_decay = jnp.exp(log_g * CHUNK)
    qc = q.reshape(B, n, CHUNK, H, RET_DK)
    kc = k.reshape(B, n, CHUNK, H, RET_DK)
    vc = v.reshape(B, n, CHUNK, H, RET_DV)
    s = jnp.einsum('bnqhd,bnkhd->bnhqk', qc, kc, preferred_element_type=jnp.float32) * intra_decay
    intra = jnp.einsum('bnhqk,bnkhe->bnqhe', s, vc.astype(jnp.float32))

    def step(state, xs):
        q_i, k_i, v_i = xs
        cross = jnp.einsum('bqhd,bhde->bqhe', q_i.astype(jnp.float32), state) * q_decay[None, :, :, None]
        kz = k_i.astype(jnp.float32) * k_decay[None, :, :, None]
        state = state * chunk_decay[None, :, None, None] + jnp.einsum('bkhd,bkhe->bhde', kz, v_i.astype(jnp.float32))
        return state, cross

    state0 = jnp.zeros((B, H, RET_DK, RET_DV), jnp.float32)
    _, cross = lax.scan(step, state0, (qc.swapaxes(0, 1), kc.swapaxes(0, 1), vc.swapaxes(0, 1)))
    out = intra + cross.swapaxes(0, 1)
    return out.reshape(B, S, H, RET_DV)


def _conv_ffn(h, w_up, conv_w, conv_b, w_down):
    a = h @ w_up
    S = a.shape[1]
    ap = jnp.pad(a, ((0, 0), (CONV_WIDTH - 1, 0), (0, 0)))
    c = conv_b
    for j in range(CONV_WIDTH):
        c = c + ap[:, j:j + S] * conv_w[j]
    gate, val = jnp.split(c, 2, axis=-1)
    return (jax.nn.gelu(gate) * val) @ w_down


def setup_inputs(seed: int = 0) -> dict:
    key = jax.random.key(seed)
    ks = jax.random.split(key, 32)
    f32 = jnp.float32

    def nrm(k, shape, scale):
        return jax.random.normal(k, shape, f32) * scale

    def gain(k, shape):
        return 1.0 + 0.01 * jax.random.normal(k, shape, f32)

    x = nrm(ks[0], (BATCH, SEQ, D_MODEL), 1.0)
    p = nrm(ks[1], (DEPTH, BATCH, SEQ, PLE_DIM), 1.0)
    positions = (jax.random.randint(ks[2], (BATCH, 1), 0, MAX_OFFSET, dtype=jnp.int32)
                 + jnp.arange(SEQ, dtype=jnp.int32)[None, :])
    return {
        'x': x,
        'p': p,
        'positions': positions,
        'mix_norm_g': gain(ks[3], (DEPTH, D_MODEL)),
        'even_w_in': nrm(ks[4], (N_EVEN, D_MODEL, EVEN_IN_WIDTH), D_MODEL ** -0.5),
        'mla_q_norm_g': gain(ks[5], (N_EVEN, Q_LORA)),
        'mla_w_q_up': nrm(ks[6], (N_EVEN, Q_LORA, MLA_HEADS * (MLA_NOPE + MLA_ROPE)), Q_LORA ** -0.5),
        'mla_kv_norm_g': gain(ks[7], (N_EVEN, KV_LORA)),
        'mla_w_kv_up': nrm(ks[8], (N_EVEN, KV_LORA, MLA_HEADS * (MLA_NOPE + MLA_VDIM)), KV_LORA ** -0.5),
        'sgu_ln_g': gain(ks[9], (N_EVEN, SGU_WIDTH)),
        'sgu_ln_b': nrm(ks[10], (N_EVEN, SGU_WIDTH), 0.01),
        'sgu_w_s': nrm(ks[11], (N_EVEN, SGU_GROUPS, SGU_BLOCK, SGU_BLOCK), SGU_BLOCK ** -0.5),
        'sgu_b_s': gain(ks[12], (N_EVEN, SGU_GROUPS, SGU_BLOCK)),
        'even_w_out': nrm(ks[13], (N_EVEN, EVEN_OUT_WIDTH, D_MODEL), EVEN_OUT_WIDTH ** -0.5),
        'ret_w_in': nrm(ks[14], (N_ODD, D_MODEL, RET_IN_WIDTH), D_MODEL ** -0.5),
        'ret_gn_g': gain(ks[15], (N_ODD, RET_V_WIDTH)),
        'ret_gn_b': nrm(ks[16], (N_ODD, RET_V_WIDTH), 0.01),
        'ret_w_out': nrm(ks[17], (N_ODD, RET_V_WIDTH, D_MODEL), RET_V_WIDTH ** -0.5),
        'ffn_norm_g': gain(ks[18], (DEPTH, D_MODEL)),
        'ffn_w_up': nrm(ks[19], (DEPTH, D_MODEL, 2 * D_FF), D_MODEL ** -0.5),
        'ffn_conv_w': nrm(ks[20], (DEPTH, CONV_WIDTH, 2 * D_FF), CONV_WIDTH ** -0.5),
        'ffn_conv_b': nrm(ks[21], (DEPTH, 2 * D_FF), 0.01),
        'ffn_w_down': nrm(ks[22], (DEPTH, D_FF, D_MODEL), D_FF ** -0.5),
        'ple_norm_g': gain(ks[23], (DEPTH, D_MODEL)),
        'ple_w_gate': nrm(ks[24], (DEPTH, D_MODEL, D_MODEL), D_MODEL ** -0.5),
        'ple_w_up': nrm(ks[25], (DEPTH, PLE_DIM, D_MODEL), PLE_DIM ** -0.5),
        'final_norm_g': gain(ks[26], (D_MODEL,)),
    }


def reference(x, p, positions, mix_norm_g, even_w_in, mla_q_norm_g, mla_w_q_up,
              mla_kv_norm_g, mla_w_kv_up, sgu_ln_g, sgu_ln_b, sgu_w_s, sgu_b_s,
              even_w_out, ret_w_in, ret_gn_g, ret_gn_b, ret_w_out, ffn_norm_g,
              ffn_w_up, ffn_conv_w, ffn_conv_b, ffn_w_down, ple_norm_g, ple_w_gate,
              ple_w_up, final_norm_g):
    B, S, _ = x.shape
    h = x
    for i in range(DEPTH):
        hn = _rms_norm(h, mix_norm_g[i])
        if i % 2 == 0:
            j = i // 2
            z = hn @ even_w_in[j]
            c_q, c_kv, k_pe, u, v = jnp.split(z, EVEN_SPLITS, axis=-1)
            a_out = _mla(c_q, c_kv, k_pe, positions, mla_q_norm_g[j], mla_w_q_up[j],
                         mla_kv_norm_g[j], mla_w_kv_up[j])
            b_out = _sgu(u, v, sgu_ln_g[j], sgu_ln_b[j], sgu_w_s[j], sgu_b_s[j])
            h = h + jnp.concatenate([a_out, b_out], axis=-1) @ even_w_out[j]
        else:
            j = i // 2
            z = hn @ ret_w_in[j]
            q, k, v, g = jnp.split(z, RET_SPLITS, axis=-1)
            r = _retention(q.reshape(B, S, RET_HEADS, RET_DK),
                           k.reshape(B, S, RET_HEADS, RET_DK),
                           v.reshape(B, S, RET_HEADS, RET_DV), positions)
            r = _layer_norm(r, ret_gn_g[j].reshape(RET_HEADS, RET_DV),
                            ret_gn_b[j].reshape(RET_HEADS, RET_DV))
            r = r.reshape(B, S, RET_V_WIDTH).astype(h.dtype) * jax.nn.silu(g)
            h = h + r @ ret_w_out[j]
        h = h + _conv_ffn(_rms_norm(h, ffn_norm_g[i]), ffn_w_up[i], ffn_conv_w[i],
                          ffn_conv_b[i], ffn_w_down[i])
        gate = jax.nn.sigmoid(_rms_norm(h, ple_norm_g[i]) @ ple_w_gate[i])
        h = h + (p[i] @ ple_w_up[i]) * gate
    return _rms_norm(h, final_norm_g)
```

```cpp
#include <hip/hip_runtime.h>
#include <cstdio>
#include <cstdint>

#ifndef MK_ONE_LAUNCH
#define MK_ONE_LAUNCH 1
#endif

#define LAS __attribute__((address_space(3)))
#define GAS __attribute__((address_space(1)))
typedef unsigned short bf16_t;
typedef short bf16x8 __attribute__((ext_vector_type(8)));
typedef float f32x4 __attribute__((ext_vector_type(4)));
typedef float f32x2 __attribute__((ext_vector_type(2)));
typedef float f32x16 __attribute__((ext_vector_type(16)));
typedef unsigned u32x4 __attribute__((ext_vector_type(4)));
typedef unsigned u32x2 __attribute__((ext_vector_type(2)));
typedef _Float16 f16v2 __attribute__((ext_vector_type(2)));

constexpr int NB = 16, SEQ = 2048, T = NB * SEQ, D = 2048, DEPTH = 4;
constexpr int QL = 512, KVL = 256, HM = 8, QKD = 192;
constexpr int EIN = 2880, EINP = 3072, QUPN = 1536;
constexpr int RIN = 12288, RV = 4096;
constexpr int FF = 5632, FF2 = 11264, PLE = 256;
constexpr float EPS = 1e-6f;

constexpr size_t MiB = 1u << 20;
constexpr size_t WS_CTL = 0, CTL_ZERO_BYTES = 65536;
constexpr size_t WS_TABM = 1 * MiB;
constexpr size_t WS_TABR = 9 * MiB;
constexpr size_t WS_PSH0 = 41 * MiB, WS_PSH1 = 45 * MiB;
constexpr size_t WS_PSQ = 49 * MiB;
constexpr size_t WS_PSKV = 50 * MiB;
constexpr size_t WS_PSV = 51 * MiB;
constexpr size_t WS_SIDE = 55 * MiB;
constexpr size_t WS_HB0 = 77 * MiB, WS_HB1 = 205 * MiB;
constexpr size_t WS_PBF = 333 * MiB;
constexpr size_t WS_WMIX = 349 * MiB;
constexpr size_t WS_WFFN = 413 * MiB;
constexpr size_t WS_WPLE = 479 * MiB;
constexpr size_t WS_ACT = 488 * MiB;
constexpr size_t WS_END = WS_ACT + 768 * MiB;
constexpr size_t WM_EIN = 0, WM_QUP = 12 * MiB, WM_KVK = 14 * MiB, WM_KVV = 15 * MiB, WM_EOUT = 16 * MiB, WM_WS = 24 * MiB;
constexpr size_t WM_RIN = 0, WM_ROUT = 48 * MiB;
constexpr size_t WF_UP = 0, WF_DN = 44 * MiB, WP_G = 0, WP_U = 8 * MiB;
constexpr size_t A_CQ = 0, A_CKV = 32 * MiB, A_KROT = 48 * MiB, A_UG = 52 * MiB, A_VG = 116 * MiB, A_Q = 180 * MiB, A_KN = 276 * MiB, A_VT = 340 * MiB, A_AB = 404 * MiB;
constexpr size_t A_RQ = 0, A_RK = 128 * MiB, A_RVV = 256 * MiB, A_RSG = 512 * MiB;
constexpr size_t A_M = 0, A_UPV = 384 * MiB;
constexpr int CW_BAR = 4096;
constexpr size_t SLAB = 96 * MiB;
constexpr int VTP = T / 8;

constexpr int LDS_BYTES = 163840;
constexpr int LDS_XCH = 131072;
constexpr int LDS_MISC = 163840 - 256;

#define LDS_WAIT() asm volatile("s_waitcnt lgkmcnt(0)" ::: "memory")
#define VM_WAIT() asm volatile("s_waitcnt vmcnt(0)" ::: "memory")
__device__ __forceinline__ unsigned f2bf(float f) { unsigned u = __float_as_uint(f); return (u + 0x7fffu + ((u >> 16) & 1u)) >> 16; }
typedef __bf16 bf16v2 __attribute__((ext_vector_type(2)));
__device__ __forceinline__ unsigned pk2(float lo, float hi) { const f32x2 v = {lo, hi}; return __builtin_bit_cast(unsigned, __builtin_convertvector(v, bf16v2)); }
__device__ __forceinline__ float bf_lo(unsigned w) { return __uint_as_float(w << 16); }
__device__ __forceinline__ float bf_hi(unsigned w) { return __uint_as_float(w & 0xffff0000u); }
__device__ __forceinline__ float fexp2(float x) { return __builtin_amdgcn_exp2f(x); }
__device__ __forceinline__ float frcp(float x) { return __builtin_amdgcn_rcpf(x); }
__device__ __forceinline__ float gelu_t(float x) { const float t = x * (-2.302208198f - 0.1029432397f * (x * x)); return x * frcp(1.0f + fexp2(t)); }
__device__ __forceinline__ float sigmoid_f(float x) { return frcp(1.0f + fexp2(-1.442695041f * x)); }
__device__ __forceinline__ float dot4(f32x4 a) { return (a[0] * a[0] + a[1] * a[1]) + (a[2] * a[2] + a[3] * a[3]); }
__device__ __forceinline__ float sum4(f32x4 a) { return (a[0] + a[1]) + (a[2] + a[3]); }
__device__ __forceinline__ u32x4 pack8(f32x4 a, f32x4 b) { u32x4 w; w.x = pk2(a[0], a[1]); w.y = pk2(a[2], a[3]); w.z = pk2(b[0], b[1]); w.w = pk2(b[2], b[3]); return w; }
template <int CTRL> __device__ __forceinline__ float dppf(float v) { return __int_as_float(__builtin_amdgcn_mov_dpp(__float_as_int(v), CTRL, 0xf, 0xf, true)); }
template <int CTRL> __device__ __forceinline__ f32x4 dpp4(f32x4 v) { f32x4 r; r[0] = dppf<CTRL>(v[0]); r[1] = dppf<CTRL>(v[1]); r[2] = dppf<CTRL>(v[2]); r[3] = dppf<CTRL>(v[3]); return r; }
__device__ __forceinline__ float wave_sum(float v) {
#pragma unroll
    for (int o = 1; o < 64; o <<= 1) v += __shfl_xor(v, o);
    return v;
}

__device__ __forceinline__ int lane_id_now() { int l; asm volatile("v_mbcnt_lo_u32_b32 %0, -1, 0\n\tv_mbcnt_hi_u32_b32 %0, -1, %0" : "=v"(l)); return l; }
namespace pg8 {
#define PG8_LAS __attribute__((address_space(3)))
typedef unsigned short bf16_t;
typedef short bf16x8 __attribute__((ext_vector_type(8)));
typedef float f32x4 __attribute__((ext_vector_type(4)));
typedef unsigned u32x4 __attribute__((ext_vector_type(4)));
constexpr int BM = 256, BK = 64, HALF = 128, HTB = HALF * BK * 2  , STAGE_BYTES = 8 * HTB, NXCD = 8, WGM = 8;

__host__ __device__ __forceinline__ int lds_byte(int r, int c) { const int st = (r >> 4) * 2 + (c >> 5), rr = r & 15, cc = c & 31, ob = rr * 64 + cc * 2; return st * 1024 + (ob ^ (((ob >> 9) & 1) << 5)); }
__host__ __device__ __forceinline__ void stage_rc(int b, int& R, int& C) { const int st = b / 1024, sb = b % 1024, swz = sb ^ (((sb >> 9) & 1) << 5); R = (st >> 1) * 16 + swz / 64; C = (st & 1) * 32 + (swz % 64) / 2; }
__host__ __device__ __forceinline__ int perm32(int rho) { const int n = rho >> 4, i = rho & 15; return 8 * (i >> 2) + 4 * n + (i & 3); }

struct Unit { int pm, pn; };
struct Gemm { const bf16_t* A; const bf16_t* Bt; int M, N, K; };

struct StaticOrder {
    int nM, nN, nwg, G, c;
    __host__ __device__ void init(int M, int N, int G_, int c_) { nM = M / BM; nN = N / BM; nwg = nM * nN; G = G_; c = c_; }
    __host__ __device__ bool next(int i, Unit& u) const {
        const long L = (long)i * G + c; if (L >= nwg) return false;
        int wgid = (int)L; { const int q = nwg / NXCD, r = nwg % NXCD, xcd = wgid % NXCD, off = wgid / NXCD; wgid = (xcd < r ? xcd * (q + 1) : r * (q + 1) + (xcd - r) * q) + off; }
        const int nig = WGM * nN, gid = wgid / nig, fm = gid * WGM, gsz = (nM - fm) < WGM ? (nM - fm) : WGM;
        u.pm = fm + ((wgid % nig) % gsz); u.pn = (wgid % nig) / gsz; return true;
    }
    __device__ __forceinline__ void a_ready(const Unit&) const {}
    __device__ __forceinline__ void done(const Unit&) const {}
};


#define EPI_FENCE() asm volatile("" ::: "memory")
#define EPI_ROWS(ai, m) _Pragma("unroll") for (int ai = 0; ai < 2; ++ai) _Pragma("unroll") for (int m = 0; m < 4; ++m)
template <int NP> __device__ __forceinline__ void load_rstd(const float* ps, int rowb, int fq, float inv_dim, float (&rs)[2][4]) {
    float s[2][4];
    EPI_ROWS(ai, m) {
        const float* p = ps + (size_t)(rowb + ai * 128 + m * 16) * NP + fq * (NP / 4);
        if constexpr (NP == 8) { const f32x2 a = *(const GAS f32x2*)p; s[ai][m] = a[0] + a[1]; } else s[ai][m] = *(const GAS float*)p;
    }
    EPI_ROWS(ai, m) { float t = s[ai][m]; t += __shfl_xor(t, 16); t += __shfl_xor(t, 32); rs[ai][m] = rsqrtf(t * inv_dim + EPS); }
}
template <int NP> __device__ __forceinline__ void ps_dma(const float* ps, PG8_LAS float* psl, const Unit& u, int wr, int wc, int fr, int fq) {
    const int wid = wr * 4 + wc, lane = fq * 16 + fr;
    if (NP == 8 || wid < 4) __builtin_amdgcn_global_load_lds((const unsigned*)(ps + (size_t)u.pm * BM * NP + (wid * 64 + lane) * 4), (PG8_LAS unsigned*)(psl + wid * 256), 16, 0, 0);
}
template <int NP> __device__ __forceinline__ void lds_rstd(const PG8_LAS float* psl, int wr, int fr, float inv_dim, float (&rs)[2][4]) {
    EPI_ROWS(ai, m) { const PG8_LAS float* p = psl + (ai * 128 + wr * 64 + m * 16 + fr) * NP; float t;
        if constexpr (NP == 8) { const f32x4 a = *(const PG8_LAS f32x4*)p, b = *(const PG8_LAS f32x4*)(p + 4); t = sum4(a) + sum4(b); } else { const f32x4 a = *(const PG8_LAS f32x4*)p; t = sum4(a); }
        rs[ai][m] = rsqrtf(t * inv_dim + EPS); }
}
struct NoPre {};
__device__ __forceinline__ void rope8(f32x4 t0, f32x4 t1, f32x4 t2, f32x4 t3, f32x4 x1a, f32x4 x1b, f32x4 x2a, f32x4 x2b, float sc, u32x4& o1, u32x4& o2) {
    x1a *= sc; x1b *= sc; x2a *= sc; x2b *= sc;
    f32x4 ra, rb, qa, qb;
    ra[0] = x1a[0] * t0[0] - x2a[0] * t0[1]; qa[0] = x2a[0] * t0[0] + x1a[0] * t0[1];
    ra[1] = x1a[1] * t0[2] - x2a[1] * t0[3]; qa[1] = x2a[1] * t0[2] + x1a[1] * t0[3];
    ra[2] = x1a[2] * t1[0] - x2a[2] * t1[1]; qa[2] = x2a[2] * t1[0] + x1a[2] * t1[1];
    ra[3] = x1a[3] * t1[2] - x2a[3] * t1[3]; qa[3] = x2a[3] * t1[2] + x1a[3] * t1[3];
    rb[0] = x1b[0] * t2[0] - x2b[0] * t2[1]; qb[0] = x2b[0] * t2[0] + x1b[0] * t2[1];
    rb[1] = x1b[1] * t2[2] - x2b[1] * t2[3]; qb[1] = x2b[1] * t2[2] + x1b[1] * t2[3];
    rb[2] = x1b[2] * t3[0] - x2b[2] * t3[1]; qb[2] = x2b[2] * t3[0] + x1b[2] * t3[1];
    rb[3] = x1b[3] * t3[2] - x2b[3] * t3[3]; qb[3] = x2b[3] * t3[2] + x1b[3] * t3[3];
    o1 = pack8(ra, rb); o2 = pack8(qa, qb);
}
__device__ __forceinline__ void row_ss_reduce(PG8_LAS float* red, float* ps, const float (&ss)[2][4], const Unit& u, int wr, int wc, int fr, int fq) {
    if (fq == 0) { EPI_ROWS(ai, m) red[(ai * HALF + wr * 64 + m * 16 + fr) * 4 + wc] = ss[ai][m]; }
    asm volatile("s_waitcnt lgkmcnt(0)" ::: "memory"); __builtin_amdgcn_s_barrier(); asm volatile("" ::: "memory");
    const int t = wr * 256 + wc * 64 + fq * 16 + fr;
    if (t < 256) { const f32x4 v = *(const PG8_LAS f32x4*)(red + t * 4); *(GAS float*)(ps + (size_t)(u.pm * BM + t) * 8 + u.pn) = sum4(v); }
}

__device__ __forceinline__ void unpack8(u32x4 w, f32x4& a, f32x4& b) { a[0] = bf_lo(w.x); a[1] = bf_hi(w.x); a[2] = bf_lo(w.y); a[3] = bf_hi(w.y); b[0] = bf_lo(w.z); b[1] = bf_hi(w.z); b[2] = bf_lo(w.w); b[3] = bf_hi(w.w); }
struct EpiResid {
    static constexpr bool PERM = true, AFTER_DRAIN = false;
    typedef NoPre Pre; __device__ __forceinline__ void prefetch(Pre&, const Unit&, int, int, int, int) const {}
    const bf16_t* hin; bf16_t* hb; float* ps; PG8_LAS float* red;
    __device__ __forceinline__ void operator()(f32x4 (&acc)[2][2][4][2], const Unit& u, int wr, int wc, int fr, int fq, const Pre& pre) const {
        asm volatile("" : "+v"(fr), "+v"(fq));
        const int row0 = u.pm * BM + wr * 64 + fr, col0 = u.pn * BM + wc * 32 + 8 * fq;
        float ssr[2][4];
#pragma unroll
        for (int ai = 0; ai < 2; ++ai) {
            u32x4 bv[4][2];
#pragma unroll
            for (int m = 0; m < 4; ++m)
#pragma unroll
                for (int bj = 0; bj < 2; ++bj) bv[m][bj] = *(const GAS u32x4*)(hin + (size_t)(row0 + ai * HALF + m * 16) * D + col0 + bj * HALF);
#pragma unroll
            for (int m = 0; m < 4; ++m) {
                const size_t off = (size_t)(row0 + ai * HALF + m * 16) * D + col0; float ss = 0.f;
#pragma unroll
                for (int bj = 0; bj < 2; ++bj) {
                    f32x4 b0, b1; unpack8(bv[m][bj], b0, b1);
                    const f32x4 v0 = acc[ai][bj][m][0] + b0, v1 = acc[ai][bj][m][1] + b1;
                    *(GAS u32x4*)(hb + off + bj * HALF) = pack8(v0, v1); ss += dot4(v0) + dot4(v1);
                }
                ss += __shfl_xor(ss, 16); ss += __shfl_xor(ss, 32); ssr[ai][m] = ss;
            }
            EPI_FENCE();
        }
        row_ss_reduce(red, ps, ssr, u, wr, wc, fr, fq);
    }
};
struct EpiPle {
    static constexpr bool PERM = true, AFTER_DRAIN = false;
    typedef NoPre Pre; __device__ __forceinline__ void prefetch(Pre&, const Unit& u, int wr, int wc, int fr, int fq) const { asm volatile("" : "+v"(fr), "+v"(fq)); ps_dma<8>(ps_in, psl, u, wr, wc, fr, fq); }
    const bf16_t* hin; const bf16_t* upv; bf16_t* hb; const float* ps_in; float* ps_out; PG8_LAS float* red; PG8_LAS float* psl;
    __device__ __forceinline__ void operator()(f32x4 (&acc)[2][2][4][2], const Unit& u, int wr, int wc, int fr, int fq, const Pre& pre) const {
        asm volatile("" : "+v"(fr), "+v"(fq));
        const int row0 = u.pm * BM + wr * 64 + fr, col0 = u.pn * BM + wc * 32 + 8 * fq;
        float rs[2][4]; lds_rstd<8>(psl, wr, fr, 1.0f / D, rs);
        float ssr[2][4];
#pragma unroll
        for (int ai = 0; ai < 2; ++ai) {
            u32x4 bv[4][2], uv[4][2];
#pragma unroll
            for (int m = 0; m < 4; ++m)
#pragma unroll
                for (int bj = 0; bj < 2; ++bj) { const size_t off = (size_t)(row0 + ai * HALF + m * 16) * D + col0 + bj * HALF; bv[m][bj] = *(const GAS u32x4*)(hin + off); uv[m][bj] = *(const GAS u32x4*)(upv + off); }
#pragma unroll
            for (int m = 0; m < 4; ++m) {
                const size_t off = (size_t)(row0 + ai * HALF + m * 16) * D + col0; float ss = 0.f; const float r = rs[ai][m];
#pragma unroll
                for (int bj = 0; bj < 2; ++bj) {
                    f32x4 v0, v1, u0, u1; unpack8(bv[m][bj], v0, v1); unpack8(uv[m][bj], u0, u1);
                    const f32x4 a0 = acc[ai][bj][m][0] * r, a1 = acc[ai][bj][m][1] * r;
#pragma unroll
                    for (int i = 0; i < 4; ++i) { v0[i] += u0[i] * sigmoid_f(a0[i]); v1[i] += u1[i] * sigmoid_f(a1[i]); }
                    *(GAS u32x4*)(hb + off + bj * HALF) = pack8(v0, v1); ss += dot4(v0) + dot4(v1);
                }
                ss += __shfl_xor(ss, 16); ss += __shfl_xor(ss, 32); ssr[ai][m] = ss;
            }
            EPI_FENCE();
        }
        row_ss_reduce(red, ps_out, ssr, u, wr, wc, fr, fq);
    }
};
struct EpiStore {
    static constexpr bool PERM = true, AFTER_DRAIN = false;
    typedef NoPre Pre; __device__ __forceinline__ void prefetch(Pre&, const Unit&, int, int, int, int) const {}
    bf16_t* o; int ldc;
    __device__ __forceinline__ void operator()(f32x4 (&acc)[2][2][4][2], const Unit& u, int wr, int wc, int fr, int fq, const Pre& pre) const {
        asm volatile("" : "+v"(fr), "+v"(fq));
        const int row0 = u.pm * BM + wr * 64 + fr, col0 = u.pn * BM + wc * 32 + 8 * fq;
        EPI_ROWS(ai, m) {
            const size_t off = (size_t)(row0 + ai * HALF + m * 16) * ldc + col0;
#pragma unroll
            for (int bj = 0; bj < 2; ++bj) *(GAS u32x4*)(o + off + bj * HALF) = pack8(acc[ai][bj][m][0], acc[ai][bj][m][1]);
        }
    }
};
__device__ __forceinline__ f32x4 h2x2_f32(unsigned w0, unsigned w1) { const f16v2 a = __builtin_bit_cast(f16v2, w0), b = __builtin_bit_cast(f16v2, w1); return (f32x4){(float)a[0], (float)a[1], (float)b[0], (float)b[1]}; }
template <bool TABH> __device__ __forceinline__ void rope_tile(f32x4 (&acc)[2][2][4][2], const float (&rs)[2][4], float sc, const float* tab, int tpitch, int tcol, bf16_t* d1, bf16_t* d2, size_t dpitch, int row0) {
#pragma unroll
    for (int ai = 0; ai < 2; ++ai)
#pragma unroll
        for (int mp = 0; mp < 2; ++mp) {
            f32x4 tv[2][4]; u32x4 tw[2][2];
#pragma unroll
            for (int mm = 0; mm < 2; ++mm) {
                if constexpr (TABH) { const GAS u32x4* tp = (const GAS u32x4*)((const unsigned*)tab + (size_t)(row0 + ai * HALF + (2 * mp + mm) * 16) * tpitch + tcol); tw[mm][0] = tp[0]; tw[mm][1] = tp[1]; }
                else { const GAS f32x4* tp = (const GAS f32x4*)(tab + ((size_t)(row0 + ai * HALF + (2 * mp + mm) * 16) * tpitch + tcol) * 2); tv[mm][0] = tp[0]; tv[mm][1] = tp[1]; tv[mm][2] = tp[2]; tv[mm][3] = tp[3]; }
            }
#pragma unroll
            for (int mm = 0; mm < 2; ++mm) { const int m = 2 * mp + mm; const size_t row = (size_t)(row0 + ai * HALF + m * 16); u32x4 o1, o2;
                if constexpr (TABH) { tv[mm][0] = h2x2_f32(tw[mm][0].x, tw[mm][0].y); tv[mm][1] = h2x2_f32(tw[mm][0].z, tw[mm][0].w); tv[mm][2] = h2x2_f32(tw[mm][1].x, tw[mm][1].y); tv[mm][3] = h2x2_f32(tw[mm][1].z, tw[mm][1].w); }
                rope8(tv[mm][0], tv[mm][1], tv[mm][2], tv[mm][3], acc[ai][0][m][0], acc[ai][0][m][1], acc[ai][1][m][0], acc[ai][1][m][1], rs[ai][m] * sc, o1, o2);
                *(GAS u32x4*)(d1 + row * dpitch) = o1; *(GAS u32x4*)(d2 + row * dpitch) = o2; }
            EPI_FENCE();
        }
}
struct EpiE1 {
    static constexpr bool PERM = true, AFTER_DRAIN = false;
    typedef NoPre Pre; __device__ __forceinline__ void prefetch(Pre&, const Unit& u, int wr, int wc, int fr, int fq) const { asm volatile("" : "+v"(fr), "+v"(fq)); ps_dma<8>(ps, psl, u, wr, wc, fr, fq); }
    const float* ps; bf16_t *cq, *ckv, *krot, *ug, *vg; float *psq, *pskv, *psv; const float* tabm; PG8_LAS float* psl;
    __device__ __forceinline__ void operator()(f32x4 (&acc)[2][2][4][2], const Unit& u, int wr, int wc, int fr, int fq, const Pre& pre) const {
        asm volatile("" : "+v"(fr), "+v"(fq));
        const int row0 = u.pm * BM + wr * 64 + fr, cw = wc * 32 + 8 * fq, pn = u.pn;
        float rs[2][4]; lds_rstd<8>(psl, wr, fr, 1.0f / D, rs);
        if (pn < 2) {
            EPI_ROWS(ai, m) {
                const int row = row0 + ai * HALF + m * 16; const float r = rs[ai][m]; float ss = 0.f;
#pragma unroll
                for (int bj = 0; bj < 2; ++bj) { const f32x4 v0 = acc[ai][bj][m][0] * r, v1 = acc[ai][bj][m][1] * r;
                    *(GAS u32x4*)(cq + (size_t)row * QL + pn * 256 + bj * HALF + cw) = pack8(v0, v1); ss += dot4(v0) + dot4(v1); }
                ss += __shfl_xor(ss, 16); ss += __shfl_xor(ss, 32);
                if (fq == 0) *(GAS float*)(psq + (size_t)row * 8 + pn * 4 + wc) = ss;
                EPI_FENCE();
            }
        } else if (pn == 2) {
            EPI_ROWS(ai, m) {
                const int row = row0 + ai * HALF + m * 16; const float r = rs[ai][m]; float ss = 0.f;
#pragma unroll
                for (int bj = 0; bj < 2; ++bj) { const f32x4 v0 = acc[ai][bj][m][0] * r, v1 = acc[ai][bj][m][1] * r;
                    *(GAS u32x4*)(ckv + (size_t)row * KVL + bj * HALF + cw) = pack8(v0, v1); ss += dot4(v0) + dot4(v1); }
                ss += __shfl_xor(ss, 16); ss += __shfl_xor(ss, 32);
                if (fq == 0) *(GAS float*)(pskv + (size_t)row * 4 + wc) = ss;
                EPI_FENCE();
            }
        } else if (pn < 11) {
            const bool isv = pn >= 7; bf16_t* dst = isv ? vg : ug; const int colt = (isv ? pn - 7 : pn - 3) * 256;
            EPI_ROWS(ai, m) {
                const int row = row0 + ai * HALF + m * 16; const float r = rs[ai][m]; float s1 = 0.f, s2 = 0.f;
#pragma unroll
                for (int bj = 0; bj < 2; ++bj) { f32x4 v0 = acc[ai][bj][m][0] * r, v1 = acc[ai][bj][m][1] * r;
                    if (isv) {
#pragma unroll
                        for (int i = 0; i < 4; ++i) { v0[i] = gelu_t(v0[i]); v1[i] = gelu_t(v1[i]); } }
                    *(GAS u32x4*)(dst + (size_t)row * 1024 + colt + bj * HALF + cw) = pack8(v0, v1); s1 += sum4(v0) + sum4(v1); s2 += dot4(v0) + dot4(v1); }
                if (isv) { s1 += __shfl_xor(s1, 16); s1 += __shfl_xor(s1, 32); s2 += __shfl_xor(s2, 16); s2 += __shfl_xor(s2, 32);
                    if (fq == 0) *(GAS f32x2*)(psv + ((size_t)row * 16 + (pn - 7) * 4 + wc) * 2) = (f32x2){s1, s2}; }
                EPI_FENCE();
            }
        } else if (wc == 0) {
            rope_tile<false>(acc, rs, 1.0f, tabm, 32, 8 * fq, krot + 8 * fq, krot + 32 + 8 * fq, 64, row0);
        }
    }
};
struct EpiE2 {
    static constexpr bool PERM = true, AFTER_DRAIN = false;
    typedef NoPre Pre; __device__ __forceinline__ void prefetch(Pre&, const Unit& u, int wr, int wc, int fr, int fq) const { asm volatile("" : "+v"(fr), "+v"(fq)); ps_dma<8>(ps, psl, u, wr, wc, fr, fq); }
    const float* ps; bf16_t* q; const float* tabm; PG8_LAS float* psl;
    __device__ __forceinline__ void operator()(f32x4 (&acc)[2][2][4][2], const Unit& u, int wr, int wc, int fr, int fq, const Pre& pre) const {
        asm volatile("" : "+v"(fr), "+v"(fq));
        const int row0 = u.pm * BM + wr * 64 + fr, pn = u.pn;
        float rs[2][4]; lds_rstd<8>(psl, wr, fr, 1.0f / QL, rs);
        constexpr float QSC = 0.10411754f;
        if (pn < 4) {
            EPI_ROWS(ai, m) { const int row = row0 + ai * HALF + m * 16; const float r = rs[ai][m] * QSC;
#pragma unroll
                for (int bj = 0; bj < 2; ++bj) *(GAS u32x4*)(q + (size_t)row * QUPN + (2 * pn + bj) * QKD + wc * 32 + 8 * fq) = pack8(acc[ai][bj][m][0] * r, acc[ai][bj][m][1] * r); }
        } else {
            bf16_t* d = q + (4 * (pn - 4) + wc) * QKD + 128 + 8 * fq;
            rope_tile<false>(acc, rs, QSC, tabm, 32, 8 * fq, d, d + 32, QUPN, row0);
        }
    }
};
struct EpiE3k {
    static constexpr bool PERM = true, AFTER_DRAIN = false;
    typedef NoPre Pre; __device__ __forceinline__ void prefetch(Pre&, const Unit& u, int wr, int wc, int fr, int fq) const { asm volatile("" : "+v"(fr), "+v"(fq)); ps_dma<4>(ps, psl, u, wr, wc, fr, fq); }
    const float* ps; bf16_t* kn; PG8_LAS float* psl;
    __device__ __forceinline__ void operator()(f32x4 (&acc)[2][2][4][2], const Unit& u, int wr, int wc, int fr, int fq, const Pre& pre) const {
        asm volatile("" : "+v"(fr), "+v"(fq));
        const int row0 = u.pm * BM + wr * 64 + fr;
        float rs[2][4]; lds_rstd<4>(psl, wr, fr, 1.0f / KVL, rs);
        EPI_ROWS(ai, m) { const int row = row0 + ai * HALF + m * 16; const float r = rs[ai][m];
#pragma unroll
            for (int bj = 0; bj < 2; ++bj) *(GAS u32x4*)(kn + (size_t)row * 1024 + (2 * u.pn + bj) * 128 + wc * 32 + 8 * fq) = pack8(acc[ai][bj][m][0] * r, acc[ai][bj][m][1] * r); }
    }
};
struct EpiE3v {
    static constexpr bool PERM = true, AFTER_DRAIN = false;
    typedef NoPre Pre; __device__ __forceinline__ void prefetch(Pre&, const Unit&, int, int, int, int) const {}
    const float* ps; bf16_t* vt;
    __device__ __forceinline__ void operator()(f32x4 (&acc)[2][2][4][2], const Unit& u, int wr, int wc, int fr, int fq, const Pre& pre) const {
        asm volatile("" : "+v"(fr), "+v"(fq));
        const int row0 = u.pm * BM + wr * 64 + fr, t0 = u.pn * BM + wc * 32 + 8 * fq;
        f32x4 cs[2][2];
#pragma unroll
        for (int bj = 0; bj < 2; ++bj)
#pragma unroll
            for (int n = 0; n < 2; ++n)
#pragma unroll
                for (int i = 0; i < 4; ++i) { const f32x4 p = *(const GAS f32x4*)(ps + (size_t)(t0 + bj * HALF + 4 * n + i) * 4); cs[bj][n][i] = rsqrtf(sum4(p) * (1.0f / KVL) + EPS); }
        EPI_ROWS(ai, m) { const int row = row0 + ai * HALF + m * 16;
#pragma unroll
            for (int bj = 0; bj < 2; ++bj) *(GAS u32x4*)(vt + (size_t)row * VTP + t0 + bj * HALF) = pack8(acc[ai][bj][m][0] * cs[bj][0], acc[ai][bj][m][1] * cs[bj][1]); }
    }
};
struct EpiO1 {
    static constexpr bool PERM = true, AFTER_DRAIN = false;
    typedef NoPre Pre; __device__ __forceinline__ void prefetch(Pre&, const Unit& u, int wr, int wc, int fr, int fq) const { asm volatile("" : "+v"(fr), "+v"(fq)); ps_dma<8>(ps, psl, u, wr, wc, fr, fq); }
    const float* ps; bf16_t *rq, *rk, *rv, *rsg; const float* tabr; PG8_LAS float* psl;
    __device__ __forceinline__ void operator()(f32x4 (&acc)[2][2][4][2], const Unit& u, int wr, int wc, int fr, int fq, const Pre& pre) const {
        asm volatile("" : "+v"(fr), "+v"(fq));
        const int row0 = u.pm * BM + wr * 64 + fr, cw = wc * 32 + 8 * fq, pn = u.pn >= 16 ? u.pn - 16 : u.pn + 32;
        float rs[2][4]; lds_rstd<8>(psl, wr, fr, 1.0f / D, rs);
        if (pn < 16) {
            bf16_t* dst = (pn < 8 ? rq : rk) + (pn & 7) * 256 + cw;
            rope_tile<true>(acc, rs, pn < 8 ? 1.0f : 0.0625f, tabr, 128, cw, dst, dst + 128, 2048, row0);
        } else {
            bf16_t* dst = (pn < 32 ? rv + (pn - 16) * 256 : rsg + (pn - 32) * 256) + cw;
            EPI_ROWS(ai, m) { const int row = row0 + ai * HALF + m * 16; const float r = rs[ai][m];
#pragma unroll
                for (int bj = 0; bj < 2; ++bj) *(GAS u32x4*)(dst + (size_t)row * RV + bj * HALF) = pack8(acc[ai][bj][m][0] * r, acc[ai][bj][m][1] * r); }
        }
    }
};
struct EpiF1 {
    static constexpr bool PERM = true, AFTER_DRAIN = false;
    typedef NoPre Pre;
    __device__ __forceinline__ void prefetch(Pre&, const Unit& u, int wr, int wc, int fr, int fq) const { asm volatile("" : "+v"(fr), "+v"(fq));
        PG8_LAS float* psl = xl + 3072;
        ps_dma<8>(ps, psl, u, wr, wc, fr, fq);
        const int wid = wr * 4 + wc, lane = fq * 16 + fr;
        if (wid < 4) { const int c4 = lane * 4, wch = (c4 >> 7) * FF + u.pn * HALF + (c4 & 127);
            __builtin_amdgcn_global_load_lds((const unsigned*)((wid < 3 ? cw3 + wid * FF2 : cb) + wch), (PG8_LAS unsigned*)(xl + 2048 + wid * 256), 16, 0, 0); } }
    const float* ps; bf16_t* mo; float* side; const float* cw3; const float* cb; PG8_LAS float* xl;
    __device__ __forceinline__ void operator()(f32x4 (&acc)[2][2][4][2], const Unit& u, int wr, int wc, int fr, int fq, const Pre& pre) const {
        asm volatile("" : "+v"(fr), "+v"(fq));
        const int row0 = u.pm * BM + wr * 64 + fr, jc = wc * 32 + 8 * fq;
        PG8_LAS float* wl = xl + 2048;
        float rs[2][4]; lds_rstd<8>(xl + 3072, wr, fr, 1.0f / D, rs);
        EPI_ROWS(ai, m) { const float r = rs[ai][m];
#pragma unroll
            for (int bj = 0; bj < 2; ++bj) { acc[ai][bj][m][0] *= r; acc[ai][bj][m][1] *= r; } }
        EPI_FENCE();
        if (fr >= 14) {
#pragma unroll
            for (int ai = 0; ai < 2; ++ai)
#pragma unroll
                for (int bj = 0; bj < 2; ++bj)
#pragma unroll
                    for (int n = 0; n < 2; ++n) *(PG8_LAS f32x4*)(xl + ((ai * 2 + wr) * 2 + (fr - 14)) * 256 + bj * HALF + jc + 4 * n) = acc[ai][bj][3][n];
        }
        if (wr == 0 && fr < 2) {
#pragma unroll
            for (int bj = 0; bj < 2; ++bj)
#pragma unroll
                for (int n = 0; n < 2; ++n) *(GAS f32x4*)(side + ((size_t)(u.pm * 4 + fr)) * FF2 + bj * FF + u.pn * HALF + jc + 4 * n) = acc[0][bj][0][n];
        }
        if (wr == 1 && fr >= 14) {
#pragma unroll
            for (int bj = 0; bj < 2; ++bj)
#pragma unroll
                for (int n = 0; n < 2; ++n) *(GAS f32x4*)(side + ((size_t)(u.pm * 4 + 2 + fr - 14)) * FF2 + bj * FF + u.pn * HALF + jc + 4 * n) = acc[1][bj][3][n];
        }
        asm volatile("s_waitcnt lgkmcnt(0)" ::: "memory"); __builtin_amdgcn_s_barrier(); asm volatile("" ::: "memory");
#pragma unroll
        for (int bjj = 0; bjj < 2; ++bjj)
#pragma unroll
            for (int n = 0; n < 2; ++n) {
                const int bj = 1 - bjj;
                const int lc = bj * HALF + jc + 4 * n;
                const f32x4 w0 = *(const PG8_LAS f32x4*)(wl + lc), w1 = *(const PG8_LAS f32x4*)(wl + 256 + lc), w2 = *(const PG8_LAS f32x4*)(wl + 512 + lc), bb = *(const PG8_LAS f32x4*)(wl + 768 + lc);
                const float m1 = fr >= 1 ? 1.f : 0.f, m2 = fr >= 2 ? 1.f : 0.f;
                const f32x4 w1a = w1 * m1, w1b = w1 - w1a, w0a = w0 * m2, w0b = w0 - w0a;
#pragma unroll
                for (int ai = 0; ai < 2; ++ai) {
                    const int src = ai * 2 + wr - 1;
                    const int srcc = src < 0 ? 0 : src; const float hz = src < 0 ? 0.f : 1.f;
                    asm volatile("" : "+v"(acc[ai][bj][0][n]), "+v"(acc[ai][bj][1][n]), "+v"(acc[ai][bj][2][n]), "+v"(acc[ai][bj][3][n]));
#pragma unroll
                    for (int mm = 0; mm < 4; ++mm) {
                        const int m = 3 - mm;
                        const f32x4 cur = acc[ai][bj][m][n];
                        f32x4 r1p, r2p;
                        if (m > 0) { r1p = dpp4<0x121>(acc[ai][bj][m - 1][n]); r2p = dpp4<0x122>(acc[ai][bj][m - 1][n]); }
                        else { const f32x4 hm2 = *(const PG8_LAS f32x4*)(xl + (srcc * 2 + 0) * 256 + lc) * hz, hm1 = *(const PG8_LAS f32x4*)(xl + (srcc * 2 + 1) * 256 + lc) * hz; r1p = hm1; r2p = (fr == 0) ? hm2 : hm1; }
                        const f32x4 r1c = dpp4<0x121>(cur), r2c = dpp4<0x122>(cur);
                        acc[ai][bj][m][n] = bb + w2 * cur + w1a * r1c + w1b * r1p + w0a * r2c + w0b * r2p;
                    }
                }
                EPI_FENCE();
            }
        EPI_ROWS(ai, m) {
            const int row = row0 + ai * HALF + m * 16;
            f32x4 g0 = acc[ai][0][m][0], g1 = acc[ai][0][m][1];
#pragma unroll
            for (int i = 0; i < 4; ++i) { g0[i] = gelu_t(g0[i]) * acc[ai][1][m][0][i]; g1[i] = gelu_t(g1[i]) * acc[ai][1][m][1][i]; }
            *(GAS u32x4*)(mo + (size_t)row * FF + u.pn * HALF + jc) = pack8(g0, g1);
        }
    }
};
struct EpiNull {
    static constexpr bool PERM = true, AFTER_DRAIN = false;
    typedef NoPre Pre; __device__ __forceinline__ void prefetch(Pre&, const Unit&, int, int, int, int) const {}
    __device__ __forceinline__ void operator()(f32x4 (&acc)[2][2][4][2], const Unit& u, int wr, int wc, int fr, int fq, const Pre&) const {
        EPI_ROWS(ai, m) { asm volatile("" :: "v"(acc[ai][0][m][0]), "v"(acc[ai][0][m][1]), "v"(acc[ai][1][m][0]), "v"(acc[ai][1][m][1])); }
    }
};
#undef EPI_ROWS

template <class Epi, class Sched, bool ALIGN_EPI = false, bool SP2 = false>
__device__ __forceinline__ void gemm_phase(PG8_LAS unsigned char* lds, const Gemm g, const Sched& S, const Epi& E, int wave_id) {
    int tid_ = wave_id * 64 + lane_id_now();
    const int tid = tid_, wid = __builtin_amdgcn_readfirstlane(tid >> 6), lane = tid & 63, wr = wid >> 2, wc = wid & 3, fr = lane & 15, fq = lane >> 4;
    const int K = g.K, nt = K / BK;
    unsigned voffA[2], voffB[2];
#pragma unroll
    for (int i = 0; i < 2; ++i) { int R, C; stage_rc(tid * 16 + i * 8192, R, C); const int Rb = Epi::PERM ? ((R & ~31) + perm32(R & 31)) : R;
        voffA[i] = (unsigned)(R * K + C) * 2u; voffB[i] = (unsigned)(Rb * K + C) * 2u; }
    const size_t kstep = (size_t)(BK * 2);
    const size_t hstep = (size_t)HALF * K * 2;
    const size_t tstep = 2 * hstep;
    const unsigned ldsw = (unsigned)wid * 1024u;
    const int aoff = lds_byte(wr * 64 + fr, fq * 8), boff = lds_byte(wc * 32 + fr, fq * 8);
#define PG8_SA(b, h) (((b) * 2 + (h)) * HTB)
#define PG8_SB(b, h) ((4 + (b) * 2 + (h)) * HTB)
#define PG8_STAGE(bufoff, gbase, voff) do { _Pragma("unroll") for (int _i = 0; _i < 2; ++_i) \
        __builtin_amdgcn_global_load_lds((const unsigned*)((const char*)(gbase) + (voff)[_i]), (PG8_LAS unsigned*)(lds + (bufoff) + ldsw + _i * 8192), 16, 0, 0); } while (0)
#define PG8_LDA(dst, b, h) do { _Pragma("unroll") for (int m = 0; m < 4; ++m) _Pragma("unroll") for (int k = 0; k < 2; ++k) dst[m][k] = *(const PG8_LAS bf16x8*)(lds + PG8_SA(b, h) + aoff + m * 2048 + k * 1024); } while (0)
#define PG8_LDB(dst, b, h) do { _Pragma("unroll") for (int n = 0; n < 2; ++n) _Pragma("unroll") for (int k = 0; k < 2; ++k) dst[n][k] = *(const PG8_LAS bf16x8*)(lds + PG8_SB(b, h) + boff + n * 2048 + k * 1024); } while (0)
#define PG8_MMA(ai, bj, At, Bt) do { __builtin_amdgcn_s_setprio(1); _Pragma("unroll") for (int m = 0; m < 4; ++m) _Pragma("unroll") for (int n = 0; n < 2; ++n) _Pragma("unroll") for (int k = 0; k < 2; ++k) \
        acc[ai][bj][m][n] = __builtin_amdgcn_mfma_f32_16x16x32_bf16(Bt[n][k], At[m][k], acc[ai][bj][m][n], 0, 0, 0); __builtin_amdgcn_s_setprio(0); } while (0)
#define PG8_WAIT_V(n) asm volatile("s_waitcnt vmcnt(" #n ")" ::: "memory")
#define PG8_WAIT_L(n) asm volatile("s_waitcnt lgkmcnt(" #n ")" ::: "memory")
#define PG8_BAR __builtin_amdgcn_s_barrier()
#define PG8_SCHED __builtin_amdgcn_sched_barrier(0)
    Unit cur, nxt; int ui = 0; typename Epi::Pre pre;
    if (!S.next(0, cur)) return;
    f32x4 acc[2][2][4][2];
#pragma unroll
    for (int a = 0; a < 2; ++a)
#pragma unroll
        for (int b = 0; b < 2; ++b)
#pragma unroll
            for (int m = 0; m < 4; ++m)
#pragma unroll
                for (int n = 0; n < 2; ++n) acc[a][b][m][n] = (f32x4){0.f, 0.f, 0.f, 0.f};
    bf16x8 At[4][2], B0[2][2], B1[2][2];
    const char* cA = (const char*)g.A + (size_t)cur.pm * tstep; const char* cB = (const char*)g.Bt + (size_t)cur.pn * tstep;
    S.a_ready(cur);
    if constexpr (SP2) {
        PG8_STAGE(PG8_SB(0, 0), cB, voffB); PG8_STAGE(PG8_SB(0, 1), cB + hstep, voffB); PG8_STAGE(PG8_SA(0, 0), cA, voffA); PG8_STAGE(PG8_SA(0, 1), cA + hstep, voffA);
        if (wr == 1) PG8_BAR;
        PG8_WAIT_V(2); PG8_BAR;
        PG8_STAGE(PG8_SB(1, 0), cB + kstep, voffB); PG8_STAGE(PG8_SA(1, 0), cA + kstep, voffA); PG8_STAGE(PG8_SB(1, 1), cB + hstep + kstep, voffB);
        PG8_WAIT_V(6); PG8_BAR;
    } else {
        PG8_STAGE(PG8_SB(0, 0), cB, voffB); PG8_STAGE(PG8_SA(0, 0), cA, voffA); PG8_STAGE(PG8_SB(0, 1), cB + hstep, voffB); PG8_STAGE(PG8_SA(0, 1), cA + hstep, voffA);
        if (wr == 1) PG8_BAR;
        PG8_WAIT_V(4); PG8_BAR;
        PG8_STAGE(PG8_SB(1, 0), cB + kstep, voffB); PG8_STAGE(PG8_SA(1, 0), cA + kstep, voffA); PG8_STAGE(PG8_SB(1, 1), cB + hstep + kstep, voffB);
        PG8_WAIT_V(6); PG8_BAR;
    }
    for (;;) {
        const bool has_next = S.next(ui + 1, nxt);
        const char* nA = has_next ? (const char*)g.A + (size_t)nxt.pm * tstep : cA; const char* nB = has_next ? (const char*)g.Bt + (size_t)nxt.pn * tstep : cB;
#pragma unroll 1
        for (int t = 0; t < nt; t += 2) {
            const bool last = (t == nt - 2);
            const char* a1 = cA + (size_t)(t + 1) * kstep;
            const char* a2 = last ? nA : cA + (size_t)(t + 2) * kstep; const char* b2 = last ? nB : cB + (size_t)(t + 2) * kstep;
            const char* a3 = a2 + kstep; const char* b3 = b2 + kstep;
            if (last && has_next) S.a_ready(nxt);
            if (last) E.prefetch(pre, cur, wr, wc, fr, fq);
            if constexpr (SP2) {
            PG8_LDB(B0, 0, 0); PG8_LDB(B1, 0, 1); PG8_SCHED; PG8_LDA(At, 0, 0); PG8_STAGE(PG8_SA(1, 1), a1 + hstep, voffA);
            PG8_WAIT_V(8); PG8_WAIT_L(0); PG8_BAR; PG8_MMA(0, 0, At, B0); PG8_MMA(0, 1, At, B1); PG8_BAR; PG8_SCHED;
            PG8_LDA(At, 0, 1); PG8_STAGE(PG8_SB(0, 0), b2, voffB); PG8_STAGE(PG8_SB(0, 1), b2 + hstep, voffB); PG8_STAGE(PG8_SA(0, 0), a2, voffA);
            PG8_WAIT_V(8); PG8_WAIT_L(0); PG8_BAR; PG8_MMA(1, 0, At, B0); PG8_MMA(1, 1, At, B1); PG8_BAR; PG8_SCHED;
            PG8_LDB(B0, 1, 0); PG8_LDB(B1, 1, 1); PG8_SCHED; PG8_LDA(At, 1, 0); PG8_STAGE(PG8_SA(0, 1), a2 + hstep, voffA);
            PG8_WAIT_V(8); PG8_WAIT_L(0); PG8_BAR; PG8_MMA(0, 0, At, B0); PG8_MMA(0, 1, At, B1); PG8_BAR; PG8_SCHED;
            PG8_LDA(At, 1, 1); PG8_STAGE(PG8_SB(1, 0), b3, voffB); PG8_STAGE(PG8_SB(1, 1), b3 + hstep, voffB); PG8_STAGE(PG8_SA(1, 0), a3, voffA);
            PG8_WAIT_V(8); PG8_WAIT_L(0); PG8_BAR; PG8_MMA(1, 0, At, B0); PG8_MMA(1, 1, At, B1); PG8_BAR; PG8_SCHED;
            } else {
            PG8_LDB(B0, 0, 0); PG8_SCHED; PG8_LDA(At, 0, 0); PG8_STAGE(PG8_SA(1, 1), a1 + hstep, voffA);
            PG8_WAIT_L(8); PG8_BAR; PG8_WAIT_L(0); PG8_MMA(0, 0, At, B0); PG8_BAR; PG8_SCHED;
            PG8_LDB(B1, 0, 1); PG8_STAGE(PG8_SB(0, 0), b2, voffB);
            PG8_BAR; PG8_WAIT_L(0); PG8_MMA(0, 1, At, B1); PG8_BAR;
            PG8_LDA(At, 0, 1); PG8_STAGE(PG8_SA(0, 0), a2, voffA);
            PG8_BAR; PG8_WAIT_L(0); PG8_MMA(1, 0, At, B0); PG8_BAR; PG8_SCHED;
            PG8_STAGE(PG8_SB(0, 1), b2 + hstep, voffB);
            PG8_WAIT_V(6); PG8_BAR; PG8_MMA(1, 1, At, B1); PG8_BAR;
            PG8_LDB(B0, 1, 0); PG8_SCHED; PG8_LDA(At, 1, 0); PG8_STAGE(PG8_SA(0, 1), a2 + hstep, voffA);
            PG8_WAIT_L(8); PG8_BAR; PG8_WAIT_L(0); PG8_MMA(0, 0, At, B0); PG8_BAR; PG8_SCHED;
            PG8_LDB(B1, 1, 1); PG8_STAGE(PG8_SB(1, 0), b3, voffB);
            PG8_BAR; PG8_WAIT_L(0); PG8_MMA(0, 1, At, B1); PG8_BAR;
            PG8_LDA(At, 1, 1); PG8_STAGE(PG8_SA(1, 0), a3, voffA);
            PG8_BAR; PG8_WAIT_L(0); PG8_MMA(1, 0, At, B0); PG8_BAR; PG8_SCHED;
            PG8_STAGE(PG8_SB(1, 1), b3 + hstep, voffB);
            PG8_WAIT_V(6); PG8_BAR; PG8_MMA(1, 1, At, B1); PG8_BAR;
            }
        }
        if constexpr (ALIGN_EPI) { if (wr == 0) PG8_BAR; }
        if constexpr (!Epi::AFTER_DRAIN) { E(acc, cur, wr, wc, fr, fq, pre); S.done(cur); }
        if (!has_next) break;
#pragma unroll
        for (int a = 0; a < 2; ++a)
#pragma unroll
            for (int b = 0; b < 2; ++b)
#pragma unroll
                for (int m = 0; m < 4; ++m)
#pragma unroll
                    for (int n = 0; n < 2; ++n) acc[a][b][m][n] = (f32x4){0.f, 0.f, 0.f, 0.f};
        cur = nxt; cA = nA; cB = nB; ++ui;
        if constexpr (ALIGN_EPI) { if (wr == 1) PG8_BAR; }
    }
    PG8_WAIT_V(0);
    if constexpr (!ALIGN_EPI) { if (wr == 0) PG8_BAR; }
    PG8_BAR;
    if constexpr (Epi::AFTER_DRAIN) { E.fused(acc, cur, wr, wc, fr, fq, lds, wid, lane); S.done(cur); }
#undef PG8_SA
#undef PG8_SB
#undef PG8_STAGE
#undef PG8_LDA
#undef PG8_LDB
#undef PG8_MMA
#undef PG8_WAIT_V
#undef PG8_WAIT_L
#undef PG8_BAR
#undef PG8_SCHED
}
}

#define XB_TMO      128
#define XB_XCNT(j)  (256  + 64 * (j))
#define XB_XSUB(j)  (1280 + 64 * (j))
#define XB_XGEN(j)  (2304 + 64 * (j))
#define XB_TOP      3328
#define XB_TOPGEN   3392
#define XB_LSUB(j)  (3456 + 64 * (j))
#define XB_LGEN(j)  (4480 + 64 * (j))
#define XB_EV(i)    (5504 + 64 * (i))
#define XCD_BAR_WORDS 6528
#define XB_SPIN_CAP (1u << 18)

__device__ __forceinline__ unsigned xb_ld(unsigned* p)              { return __hip_atomic_load(p, __ATOMIC_RELAXED, __HIP_MEMORY_SCOPE_AGENT); }
__device__ __forceinline__ unsigned xb_add(unsigned* p, unsigned v) { return __hip_atomic_fetch_add(p, v, __ATOMIC_RELAXED, __HIP_MEMORY_SCOPE_AGENT); }
__device__ __forceinline__ unsigned xb_xcc_id() { return (unsigned)__builtin_amdgcn_s_getreg((3 << 11) | 20) & 0xFu; }
#define XB_SPIN(cond, bar) do { unsigned _sp = 0; while (cond) { __builtin_amdgcn_s_sleep(1); \
    if ((++_sp & 255u) == 0u) { if (xb_ld(&(bar)[XB_TMO])) break; if (_sp > XB_SPIN_CAP) { atomicAdd(&(bar)[XB_TMO], 1u); break; } } } } while (0)

struct XcdBarrier {
    unsigned* bar; unsigned x;
    volatile LAS unsigned* st;
};

__device__ __forceinline__ XcdBarrier xcd_barrier_post(unsigned* bar, volatile LAS unsigned* st) {
    XcdBarrier b; b.bar = bar; b.x = xb_xcc_id(); b.st = st;
    if (threadIdx.x == 0) st[2] = xb_add(&bar[XB_XCNT(b.x)], 1u);
    return b;
}
__device__ __forceinline__ void xcd_barrier_complete(unsigned* bar, unsigned x, unsigned& nloc, unsigned& nx, unsigned& even8) {
    const unsigned G = gridDim.x * gridDim.y * gridDim.z;
    unsigned sum, cnt, mine, bad, sp = 0u;
    for (;;) {
        sum = 0u; cnt = 0u; mine = 0u; bad = 0u;
#pragma unroll
        for (unsigned j = 0; j < 16; ++j) { const unsigned c = xb_ld(&bar[XB_XCNT(j)]); sum += c; cnt += (c > 0u) ? 1u : 0u; mine = (j == x) ? c : mine; bad |= (j < 8u) ? (c * 8u != G) : (c != 0u); }
        if (sum == G) break;
        __builtin_amdgcn_s_sleep(1);
        if ((++sp & 255u) == 0u) { if (xb_ld(&bar[XB_TMO])) break; if (sp > XB_SPIN_CAP) { atomicAdd(&bar[XB_TMO], 1u); break; } }
    }
    nloc = mine > 0u ? mine : 1u; nx = cnt > 0u ? cnt : 1u;
    even8 = (sum == G && bad == 0u) ? 1u : 0u;
}

__device__ __forceinline__ void xcd_barrier(const XcdBarrier& b) {
    asm volatile("s_waitcnt vmcnt(0)" ::: "memory");
    __syncthreads();
    if (threadIdx.x == 0) {
        unsigned* bar = b.bar;
        __builtin_amdgcn_s_waitcnt(0);
        unsigned nloc = b.st[0], nx = b.st[1];
        if (nloc == 0u) { unsigned e8; xcd_barrier_complete(bar, b.x, nloc, nx, e8); b.st[0] = nloc; b.st[1] = nx; b.st[3] = e8; }
        const unsigned old = xb_add(&bar[XB_XSUB(b.x)], 1u);
        const unsigned gen = old / nloc;
        if (old + 1u == (gen + 1u) * nloc) {
            __builtin_amdgcn_fence(__ATOMIC_RELEASE, "agent");
            asm volatile("s_waitcnt vmcnt(0)" ::: "memory");
            const unsigned og = xb_add(&bar[XB_TOP], 1u);
            const unsigned tg = og / nx;
            if (og + 1u == (tg + 1u) * nx) xb_add(&bar[XB_TOPGEN], 1u);
            else XB_SPIN(xb_ld(&bar[XB_TOPGEN]) == tg, bar);
            __builtin_amdgcn_fence(__ATOMIC_ACQUIRE, "agent");
            xb_add(&bar[XB_XGEN(b.x)], 1u);
            asm volatile("s_waitcnt vmcnt(0)" ::: "memory");
        } else {
            XB_SPIN(xb_ld(&bar[XB_XGEN(b.x)]) == gen, bar);
            __builtin_amdgcn_fence(__ATOMIC_ACQUIRE, "agent");
            asm volatile("s_waitcnt vmcnt(0)" ::: "memory");
        }
    }
    __syncthreads();
}

__device__ __forceinline__ void xcd_local_barrier(const XcdBarrier& b, int sig1 = -1, int sig2 = -1, bool rel = false) {
    asm volatile("s_waitcnt vmcnt(0)" ::: "memory");
    __syncthreads();
    if (threadIdx.x == 0) {
        unsigned* bar = b.bar;
        __builtin_amdgcn_s_waitcnt(0);
        const unsigned nloc = b.st[0];
        const unsigned old = xb_add(&bar[XB_LSUB(b.x)], 1u);
        const unsigned gen = old / nloc;
        if (old + 1u == (gen + 1u) * nloc) {
            if (rel) { __builtin_amdgcn_fence(__ATOMIC_RELEASE, "agent"); asm volatile("s_waitcnt vmcnt(0)" ::: "memory"); }
            if (sig1 >= 0) xb_add(&bar[XB_EV(sig1)], 1u);
            if (sig2 >= 0) xb_add(&bar[XB_EV(sig2)], 1u);
            xb_add(&bar[XB_LGEN(b.x)], 1u);
        } else XB_SPIN(xb_ld(&bar[XB_LGEN(b.x)]) == gen, bar);
        __builtin_amdgcn_fence(__ATOMIC_ACQUIRE, "agent");
        asm volatile("s_waitcnt vmcnt(0)" ::: "memory");
    }
    __syncthreads();
}

__device__ __forceinline__ void xcd_event_wait(const XcdBarrier& b, int ev, unsigned target, bool acq) {
    if (threadIdx.x == 0) {
        unsigned* bar = b.bar;
        XB_SPIN(xb_ld(&bar[XB_EV(ev)]) < target, bar);
        if (acq) { __builtin_amdgcn_fence(__ATOMIC_ACQUIRE, "agent"); asm volatile("s_waitcnt vmcnt(0)" ::: "memory"); }
    }
    __syncthreads();
}

struct Ctx { LAS unsigned char* lds; int tid, lane, wave, G, bid; };
__device__ __forceinline__ Ctx fresh(const Ctx& C) { Ctx R = C; const int t = C.wave * 64 + lane_id_now(); R.tid = t; R.lane = t & 63; return R; }
__device__ __forceinline__ int grp_of(const Ctx& C) { return C.bid & 7; }
__device__ __forceinline__ int rank_of(const Ctx& C) { return C.bid >> 3; }
__device__ __forceinline__ int nper_of(const Ctx& C) { return C.G >> 3; }
__device__ __forceinline__ unsigned char* actp(unsigned char* ws, const Ctx& C, size_t off, size_t shift) { return ws + WS_ACT + off / 8 + (size_t)(C.bid & 7) * (SLAB - shift); }
#define ACT_TM(ws, C, OFF, W) actp((ws), (C), (OFF), (size_t)4096 * (W) * 2)
#define ACT_VT(ws, C) actp((ws), (C), A_VT, (size_t)4096 * 2)

enum MapKind { MK_ID = 0, MK_EIN, MK_QUP, MK_KVK, MK_KVV, MK_FUP, MK_RIN };
__device__ __forceinline__ int map_col(int kind, int rho0) {
    switch (kind) {
    case MK_EIN: { if (rho0 < 768) return rho0; if (rho0 < 2816) return rho0 + 64; const int q = rho0 - 2816, bj = q >> 7, jj = q & 127; return jj < 32 ? 768 + 32 * bj + jj : -1; }
    case MK_QUP: { const int pn = rho0 >> 8, q = rho0 & 255, bj = q >> 7, jj = q & 127; if (pn < 4) return (2 * pn + bj) * QKD + jj; return (4 * (pn - 4) + (jj >> 5)) * QKD + 128 + 32 * bj; }
    case MK_KVK: return (rho0 >> 7) * 256 + (rho0 & 127);
    case MK_KVV: return (rho0 >> 7) * 256 + 128 + (rho0 & 127);
    case MK_RIN: return rho0 < 4096 ? 8192 + rho0 : rho0 - 4096;
    case MK_FUP: { const int pn = rho0 >> 8, q = rho0 & 255; return (q >> 7) * FF + pn * 128 + (q & 127); }
    default: return rho0;
    }
}
__device__ __forceinline__ void tr_item(const float* W, int Nsrc, int K, const float* gain, int kind, bf16_t* WT, int nblk, int item, LAS float* scr, int lane) {
    const int kb = item / nblk, nb = item % nblk, k0 = 64 * kb, rho0 = 32 * nb, sc0 = map_col(kind, rho0);
    if (sc0 >= 0) {
        float v[32];
        const GAS float* wp = (const GAS float*)(W + (size_t)(k0 + (lane >> 5)) * Nsrc + sc0 + (lane & 31));
#pragma unroll
        for (int i = 0; i < 32; ++i) v[i] = __builtin_nontemporal_load(wp + (size_t)(2 * i) * Nsrc);
        if (gain) { const GAS float* gp = (const GAS float*)(gain + k0 + (lane >> 5));
#pragma unroll
            for (int i = 0; i < 32; ++i) v[i] *= gp[2 * i]; }
#pragma unroll
        for (int i = 0; i < 32; ++i) scr[(2 * i + (lane >> 5)) * 33 + (lane & 31)] = v[i];
    } else {
#pragma unroll 8
        for (int i = 0; i < 32; ++i) { const int kk = 2 * i + (lane >> 5); scr[kk * 33 + (lane & 31)] = 0.f; }
    }
    LDS_WAIT();
    const int c = lane & 7;
#pragma unroll
    for (int j = 0; j < 4; ++j) { const int n = (lane >> 3) + 8 * j; const LAS float* s = scr + (8 * c) * 33 + n;
        u32x4 o; o.x = pk2(s[0 * 33], s[1 * 33]); o.y = pk2(s[2 * 33], s[3 * 33]); o.z = pk2(s[4 * 33], s[5 * 33]); o.w = pk2(s[6 * 33], s[7 * 33]);
        *(GAS u32x4*)(WT + (size_t)(rho0 + n) * K + k0 + 8 * c) = o; }
    LDS_WAIT();
}
__device__ __forceinline__ void tr_job(const Ctx& C, const float* W, const float* gain, bf16_t* WT, int Nsrc, int K, int Nout, int kind, int& base, unsigned* ctr) {
    LAS float* scr = (LAS float*)(C.lds + C.wave * 16384);
    const int nblk = Nout / 32, nit = (K / 64) * nblk;
    if (ctr) {
        volatile LAS unsigned* slot = (volatile LAS unsigned*)(C.lds + LDS_MISC + 64);
        for (;;) {
            if (C.tid == 0) *slot = __hip_atomic_fetch_add(ctr, 32u, __ATOMIC_RELAXED, __HIP_MEMORY_SCOPE_AGENT);
            __syncthreads();
            const int b = (int)*slot;
            __syncthreads();
            if (b >= nit) break;
#pragma unroll 1
            for (int q = 0; q < 4; ++q) { const int it = b + q * 8 + C.wave; if (it < nit) tr_item(W, Nsrc, K, gain, kind, WT, nblk, it, scr, C.lane); }
        }
    } else {
        const int gw = C.bid * 8 + C.wave, NGW = C.G * 8;
        int it = gw - (base % NGW); if (it < 0) it += NGW;
        for (; it < nit; it += NGW) tr_item(W, Nsrc, K, gain, kind, WT, nblk, it, scr, C.lane);
        base += nit;
    }
}
__device__ __forceinline__ void cvt_rows(const Ctx& C, const float* src, bf16_t* dst, size_t n) {
    const size_t stride = (size_t)C.G * 512 * 8;
    for (size_t i = ((size_t)C.bid * 512 + C.tid) * 8; i < n; i += stride) { const f32x4 a = *(const GAS f32x4*)(src + i), b = *(const GAS f32x4*)(src + i + 4); *(GAS u32x4*)(dst + i) = pack8(a, b); }
}

__device__ __forceinline__ void phase_init(const Ctx& C0, const float* x, const int* pos, float* tabm, float* tabr, bf16_t* hb, float* psh) {
    const Ctx C = fresh(C0);
    const size_t gt = (size_t)C.bid * 512 + C.tid, NT = (size_t)C.G * 512;
    for (size_t i = gt; i < (size_t)T * 32; i += NT) { const int t = (int)(i >> 5), j = (int)(i & 31); const float inv = powf(10000.0f, -(float)j / 32.0f), ang = (float)*(const GAS int*)(pos + t) * inv; float sn, cs; sincosf(ang, &sn, &cs); *(GAS f32x2*)(tabm + i * 2) = (f32x2){cs, sn}; }
    for (size_t i = gt; i < (size_t)T * 128; i += NT) { const int t = (int)(i >> 7), j = (int)(i & 127); const float inv = powf(10000.0f, -(float)j / 128.0f), ang = (float)*(const GAS int*)(pos + t) * inv; float sn, cs; sincosf(ang, &sn, &cs); const f16v2 hv = {(_Float16)cs, (_Float16)sn}; *(GAS unsigned*)((unsigned*)tabr + i) = __builtin_bit_cast(unsigned, hv); }
    const int gw = C.bid * 8 + C.wave, NGW = C.G * 8;
    for (int row = gw; row < T; row += NGW) {
        const float* xr = x + (size_t)row * D; float ss = 0.f;
#pragma unroll
        for (int j = 0; j < 4; ++j) { const int c = j * 512 + C.lane * 8; const f32x4 a = *(const GAS f32x4*)(xr + c), b = *(const GAS f32x4*)(xr + c + 4); *(GAS u32x4*)(hb + (size_t)row * D + c) = pack8(a, b); ss += dot4(a) + dot4(b); }
        ss = wave_sum(ss);
        if (C.lane < 8) *(GAS float*)(psh + (size_t)row * 8 + C.lane) = C.lane == 0 ? ss : 0.f;
    }
}

enum { PREP_MIX = 1, PREP_FUP = 2, PREP_PLEU = 4, PREP_FDN = 8, PREP_PLEG = 16, PREP_ALL = 31 };
__device__ __forceinline__ void phase_prep(const Ctx& C0, const void* const* in, unsigned char* ws, int L, int mask, bool dyn) {
    const Ctx C = fresh(C0);
    const int j = L >> 1; int base = 0;
    unsigned* const cq = dyn ? (unsigned*)(ws + WS_CTL) + 1024 + L * 16 : nullptr;
#define CQ(i) (dyn ? cq + (i) : nullptr)
    const float* mixg = (const float*)(const GAS float*)in[3] + (size_t)L * D;
    if (mask & PREP_MIX) {
    if ((L & 1) == 0) {
        tr_job(C, (const float*)(const GAS float*)in[4] + (size_t)j * D * EIN, mixg, (bf16_t*)(ws + WS_WMIX + WM_EIN), EIN, D, EINP, MK_EIN, base, CQ(0));
        tr_job(C, (const float*)(const GAS float*)in[6] + (size_t)j * QL * QUPN, (const float*)(const GAS float*)in[5] + (size_t)j * QL, (bf16_t*)(ws + WS_WMIX + WM_QUP), QUPN, QL, QUPN, MK_QUP, base, CQ(1));
        tr_job(C, (const float*)(const GAS float*)in[8] + (size_t)j * KVL * 2048, (const float*)(const GAS float*)in[7] + (size_t)j * KVL, (bf16_t*)(ws + WS_WMIX + WM_KVK), 2048, KVL, 1024, MK_KVK, base, CQ(2));
        tr_job(C, (const float*)(const GAS float*)in[8] + (size_t)j * KVL * 2048, (const float*)(const GAS float*)in[7] + (size_t)j * KVL, (bf16_t*)(ws + WS_WMIX + WM_KVV), 2048, KVL, 1024, MK_KVV, base, CQ(3));
        tr_job(C, (const float*)(const GAS float*)in[13] + (size_t)j * D * D, nullptr, (bf16_t*)(ws + WS_WMIX + WM_EOUT), D, D, D, MK_ID, base, CQ(4));
    } else {
        tr_job(C, (const float*)(const GAS float*)in[14] + (size_t)j * D * RIN, mixg, (bf16_t*)(ws + WS_WMIX + WM_RIN), RIN, D, RIN, MK_RIN, base, CQ(5));
        tr_job(C, (const float*)(const GAS float*)in[17] + (size_t)j * RV * D, nullptr, (bf16_t*)(ws + WS_WMIX + WM_ROUT), D, RV, D, MK_ID, base, CQ(6));
    }
    }
    if (mask & PREP_FUP) tr_job(C, (const float*)(const GAS float*)in[19] + (size_t)L * D * FF2, (const float*)(const GAS float*)in[18] + (size_t)L * D, (bf16_t*)(ws + WS_WFFN + WF_UP), FF2, D, FF2, MK_FUP, base, CQ(7));
    if (mask & PREP_FDN) tr_job(C, (const float*)(const GAS float*)in[22] + (size_t)L * FF * D, nullptr, (bf16_t*)(ws + WS_WFFN + WF_DN), D, FF, D, MK_ID, base, CQ(8));
    if (mask & PREP_PLEG) tr_job(C, (const float*)(const GAS float*)in[24] + (size_t)L * D * D, (const float*)(const GAS float*)in[23] + (size_t)L * D, (bf16_t*)(ws + WS_WPLE + WP_G), D, D, D, MK_ID, base, CQ(9));
    if (mask & PREP_PLEU) tr_job(C, (const float*)(const GAS float*)in[25] + (size_t)L * PLE * D, nullptr, (bf16_t*)(ws + WS_WPLE + WP_U), D, PLE, D, MK_ID, base, CQ(10));
    if (mask & PREP_PLEU) cvt_rows(C, (const float*)(const GAS float*)in[1] + (size_t)L * T * PLE, (bf16_t*)(ws + WS_PBF), (size_t)T * PLE);
    if ((mask & PREP_MIX) && (L & 1) == 0) {
        const float* wsrc = (const float*)(const GAS float*)in[11] + (size_t)j * 8 * 128 * 128; bf16_t* wm = (bf16_t*)(ws + WS_WMIX + WM_WS);
        for (int i = C.bid * 512 + C.tid; i < 8 * 128 * 128; i += C.G * 512) { const int p = (i >> 7) & 127, q = i & 127; *(GAS bf16_t*)(wm + i) = (bf16_t)f2bf(((p >> 6) >= (q >> 6)) ? *(const GAS float*)(wsrc + i) : 0.f); }
    }
#undef CQ
    __syncthreads();
}

#define MFMA32(a, b, c) __builtin_amdgcn_mfma_f32_32x32x16_bf16((a), (b), (c), 0, 0, 0)
#define MFMA16(a, b, c) __builtin_amdgcn_mfma_f32_16x16x32_bf16((a), (b), (c), 0, 0, 0)
constexpr int AT_KST = 200, AT_VST = 72;
constexpr int AT_KB = 64 * AT_KST * 2, AT_VB = 128 * AT_VST * 2, AT_BUF = AT_KB + AT_VB;
__device__ __forceinline__ int swap23(int r) { return (r & ~12) | ((r & 4) << 1) | ((r & 8) >> 1); }
__device__ __forceinline__ bf16x8 pack_frag(const f32x16& x, int s) {
    u32x4 p; p.x = pk2(x[8 * s + 0], x[8 * s + 1]); p.y = pk2(x[8 * s + 2], x[8 * s + 3]); p.z = pk2(x[8 * s + 4], x[8 * s + 5]); p.w = pk2(x[8 * s + 6], x[8 * s + 7]);
    return __builtin_bit_cast(bf16x8, p);
}

__device__ __forceinline__ void attn_qk(const LAS bf16_t* ks, int r, int hh, const bf16x8 (&qf)[12], f32x16 (&st)[2]) {
#pragma unroll
    for (int kb = 0; kb < 2; ++kb) {
#pragma unroll
        for (int j = 0; j < 16; ++j) st[kb][j] = 0.f;
        const LAS bf16_t* kp = ks + (32 * kb + r) * AT_KST + 8 * hh;
        bf16x8 a0 = *(const LAS bf16x8*)(kp), a1 = *(const LAS bf16x8*)(kp + 16);
#pragma unroll
        for (int s = 0; s < 12; s += 2) {
            st[kb] = MFMA32(a0, qf[s], st[kb]); if (s + 2 < 12) a0 = *(const LAS bf16x8*)(kp + 16 * (s + 2));
            st[kb] = MFMA32(a1, qf[s + 1], st[kb]); if (s + 3 < 12) a1 = *(const LAS bf16x8*)(kp + 16 * (s + 3));
        }
    }
}
__device__ __forceinline__ void attn_sm(f32x16 (&st)[2], float& mrow, float& lrow, f32x16 (&o)[4], bf16x8 (&pf)[2][2]) {
    float mx = st[0][0];
#pragma unroll
    for (int j = 1; j < 16; ++j) mx = fmaxf(mx, st[0][j]);
#pragma unroll
    for (int j = 0; j < 16; ++j) mx = fmaxf(mx, st[1][j]);
    mx = fmaxf(mx, __shfl_xor(mx, 32));
    const float mn = fmaxf(mrow, mx), alpha = fexp2(mrow - mn);
    float rsum = 0.f;
#pragma unroll
    for (int kb = 0; kb < 2; ++kb)
#pragma unroll
        for (int j = 0; j < 16; ++j) { const float p = fexp2(st[kb][j] - mn); st[kb][j] = p; rsum += p; }
    rsum += __shfl_xor(rsum, 32);
    lrow = lrow * alpha + rsum; mrow = mn;
#pragma unroll
    for (int db = 0; db < 4; ++db) o[db] *= alpha;
#pragma unroll
    for (int kb = 0; kb < 2; ++kb)
#pragma unroll
        for (int s = 0; s < 2; ++s) pf[kb][s] = pack_frag(st[kb], s);
}
__device__ __forceinline__ void attn_pv(const LAS bf16_t* vs, int r, int hh, const bf16x8 (&pf)[2][2], f32x16 (&o)[4]) {
    const LAS bf16_t* vp = vs + r * AT_VST + 8 * hh;
    bf16x8 v0 = *(const LAS bf16x8*)(vp), v1 = *(const LAS bf16x8*)(vp + 16), v2 = *(const LAS bf16x8*)(vp + 32), v3 = *(const LAS bf16x8*)(vp + 48);
#pragma unroll
    for (int db = 0; db < 4; ++db) {
        o[db] = MFMA32(v0, pf[0][0], o[db]); if (db < 3) v0 = *(const LAS bf16x8*)(vp + 32 * (db + 1) * AT_VST);
        o[db] = MFMA32(v1, pf[0][1], o[db]); if (db < 3) v1 = *(const LAS bf16x8*)(vp + 32 * (db + 1) * AT_VST + 16);
        o[db] = MFMA32(v2, pf[1][0], o[db]); if (db < 3) v2 = *(const LAS bf16x8*)(vp + 32 * (db + 1) * AT_VST + 32);
        o[db] = MFMA32(v3, pf[1][1], o[db]); if (db < 3) v3 = *(const LAS bf16x8*)(vp + 32 * (db + 1) * AT_VST + 48);
    }
}
__device__ __forceinline__ void attn_unit(const Ctx& C, const bf16_t* Q, const bf16_t* Kn, const bf16_t* Kr, const bf16_t* Vt, bf16_t* ab, int b, int h, int qt) {
    const int lane = C.lane, w8 = C.wave, r = lane & 31, hh = lane >> 5, tid = C.tid;
    const bool late = w8 >= 4;
    const int tq = b * SEQ + qt * 256 + w8 * 32 + r;
    bf16x8 qf[12];
    { const bf16_t* qp = Q + ((size_t)tq * 8 + h) * QKD + 8 * hh;
#pragma unroll
      for (int ks = 0; ks < 12; ++ks) qf[ks] = *(const GAS bf16x8*)(qp + 16 * ks); }
    const int cwv = qt * 4 + (w8 >> 1), nt = qt * 4 + 4;
    f32x16 o[4];
#pragma unroll
    for (int i = 0; i < 4; ++i)
#pragma unroll
        for (int j = 0; j < 16; ++j) o[i][j] = 0.f;
    float mrow = -1e30f, lrow = 0.f;
    const int srow = tid >> 3, c8 = tid & 7;
    const size_t tk0 = (size_t)b * SEQ + swap23(srow);
    const bf16_t* kn0 = Kn + (tk0 * 8 + h) * 128 + c8 * 8; const bf16_t* kr0 = Kr + tk0 * 64 + c8 * 8;
    const bf16_t* vt0 = Vt + (size_t)(h * 128 + srow) * VTP + (size_t)b * SEQ + c8 * 8;
    const int kd0 = (srow * AT_KST + c8 * 8) * 2, vd0 = AT_KB + (srow * AT_VST + c8 * 8) * 2;
#define AT_LOAD(kt_) do { kreg[0] = *(const GAS u32x4*)(kn0 + (size_t)(kt_) * (64 * 1024)); kreg[1] = *(const GAS u32x4*)(kn0 + (size_t)(kt_) * (64 * 1024) + 64); kreg[2] = *(const GAS u32x4*)(kr0 + (size_t)(kt_) * (64 * 64)); \
        vreg[0] = *(const GAS u32x4*)(vt0 + (kt_) * 64); vreg[1] = *(const GAS u32x4*)(vt0 + (size_t)64 * VTP + (kt_) * 64); } while (0)
#define AT_WRITE(base_) do { LAS unsigned char* nb_ = (base_); *(LAS u32x4*)(nb_ + kd0) = kreg[0]; *(LAS u32x4*)(nb_ + kd0 + 128) = kreg[1]; *(LAS u32x4*)(nb_ + kd0 + 256) = kreg[2]; \
        *(LAS u32x4*)(nb_ + vd0) = vreg[0]; *(LAS u32x4*)(nb_ + vd0 + 64 * AT_VST * 2) = vreg[1]; } while (0)
    u32x4 kreg[3], vreg[2];
    AT_LOAD(0); AT_WRITE(C.lds);
    __syncthreads();
    if (late && nt > 1) AT_LOAD(1);
    int bc = 0;
    for (int kt = 0; kt < nt; ++kt) {
        const bool more = kt + 1 < nt;
        const int bn = bc == 2 ? 0 : bc + 1;
        if (!late && more) AT_LOAD(kt + 1);
        f32x16 st[2]; bf16x8 pf[2][2];
        const bool act = kt <= cwv;
        if (act) attn_qk((const LAS bf16_t*)(C.lds + bc * AT_BUF), r, hh, qf, st);
        if (late) {
            if (more) AT_WRITE(C.lds + bn * AT_BUF);
            if (kt + 2 < nt) AT_LOAD(kt + 2);
            __syncthreads();
        }
        if (act) {
            attn_sm(st, mrow, lrow, o, pf);
            attn_pv((const LAS bf16_t*)(C.lds + bc * AT_BUF + AT_KB), r, hh, pf, o);
        }
        if (!late) {
            if (more) AT_WRITE(C.lds + bn * AT_BUF);
            __syncthreads();
        }
        bc = bn;
    }
    const float inv = 1.0f / lrow;
    const int l2_ = lane_id_now();
    bf16_t* op = ab + (size_t)(b * SEQ + qt * 256 + w8 * 32 + (l2_ & 31)) * D + h * 128 + 4 * (l2_ >> 5);
#pragma unroll
    for (int db = 0; db < 4; ++db)
#pragma unroll
        for (int g = 0; g < 4; ++g) { u32x2 w; w.x = pk2(o[db][4 * g] * inv, o[db][4 * g + 1] * inv); w.y = pk2(o[db][4 * g + 2] * inv, o[db][4 * g + 3] * inv); *(GAS u32x2*)(op + 32 * db + 8 * g) = w; }
    __syncthreads();
#undef AT_LOAD
#undef AT_WRITE
}
__device__ __forceinline__ void phase_attn(const Ctx& C0, unsigned char* ws) {
    const Ctx C = fresh(C0);
    const bf16_t* Q = (const bf16_t*)ACT_TM(ws, C, A_Q, QUPN); const bf16_t* Kn = (const bf16_t*)ACT_TM(ws, C, A_KN, 1024); const bf16_t* Kr = (const bf16_t*)ACT_TM(ws, C, A_KROT, 64);
    const bf16_t* Vt = (const bf16_t*)ACT_VT(ws, C); bf16_t* ab = (bf16_t*)ACT_TM(ws, C, A_AB, D);
    for (int li = rank_of(C); li < 32; li += nper_of(C)) {
        const int slot = grp_of(C) * 32 + li;
        const int bh = slot >> 1, b = bh >> 3, h = bh & 7, odd = slot & 1;
#pragma unroll 1
        for (int i = 0; i < 4; ++i) {
            const int big = odd ? ((i & 2) ? 5 : 6) : ((i & 2) ? 4 : 7), qt = (i & 1) ? 7 - big : big;
            attn_unit(C, Q, Kn, Kr, Vt, ab, b, h, qt);
        }
    }
}

constexpr int SG_XST = 136;
constexpr int SG_STAT = 0, SG_XT = 1024, SG_SL = SG_XT + 128 * SG_XST * 2, SG_SST = 132;
__device__ __forceinline__ void sgu_unit(const Ctx& C, const bf16_t* ug, const bf16_t* vg, const float* psv, const bf16_t* wm, const float* lng, const float* lnb, const float* bs, bf16_t* ab, int blk, int g) {
    const int tid = C.tid, lane = C.lane, w8 = C.wave, r = lane & 31, hh = lane >> 5, t0 = blk * 128;
    LAS float* stat = (LAS float*)(C.lds + SG_STAT); LAS bf16_t* xt = (LAS bf16_t*)(C.lds + SG_XT); LAS float* sl = (LAS float*)(C.lds + SG_SL);
    if (tid < 128) {
        const GAS f32x4* p = (const GAS f32x4*)(psv + (size_t)(t0 + tid) * 32); float s1 = 0.f, s2 = 0.f;
#pragma unroll
        for (int i = 0; i < 8; ++i) { const f32x4 v = p[i]; s1 += v[0] + v[2]; s2 += v[1] + v[3]; }
        const float mu = s1 * (1.0f / 1024.0f), var = s2 * (1.0f / 1024.0f) - mu * mu;
        stat[tid * 2] = mu; stat[tid * 2 + 1] = rsqrtf(fmaxf(var, 0.f) + EPS);
    }
    __syncthreads();
    {
        const int tg = tid >> 4, cg = tid & 15, c0 = g * 128 + 8 * cg;
        const f32x4 ga = *(const GAS f32x4*)(lng + c0), gb = *(const GAS f32x4*)(lng + c0 + 4), ba = *(const GAS f32x4*)(lnb + c0), bb = *(const GAS f32x4*)(lnb + c0 + 4);
        float xn[4][8];
#pragma unroll
        for (int i = 0; i < 4; ++i) {
            const u32x4 w = *(const GAS u32x4*)(vg + (size_t)(t0 + 4 * tg + i) * 1024 + c0); const float mu = stat[(4 * tg + i) * 2], rsd = stat[(4 * tg + i) * 2 + 1];
            xn[i][0] = (bf_lo(w.x) - mu) * rsd * ga[0] + ba[0]; xn[i][1] = (bf_hi(w.x) - mu) * rsd * ga[1] + ba[1]; xn[i][2] = (bf_lo(w.y) - mu) * rsd * ga[2] + ba[2]; xn[i][3] = (bf_hi(w.y) - mu) * rsd * ga[3] + ba[3];
            xn[i][4] = (bf_lo(w.z) - mu) * rsd * gb[0] + bb[0]; xn[i][5] = (bf_hi(w.z) - mu) * rsd * gb[1] + bb[1]; xn[i][6] = (bf_lo(w.w) - mu) * rsd * gb[2] + bb[2]; xn[i][7] = (bf_hi(w.w) - mu) * rsd * gb[3] + bb[3];
        }
#pragma unroll
        for (int j = 0; j < 8; ++j) { u32x2 w; w.x = pk2(xn[0][j], xn[1][j]); w.y = pk2(xn[2][j], xn[3][j]); *(LAS u32x2*)(xt + (8 * cg + j) * SG_XST + 4 * tg) = w; }
    }
    __syncthreads();
    {
        const int pb = w8 >> 1, cb0 = 2 * (w8 & 1);
        f32x16 acc[2];
#pragma unroll
        for (int i = 0; i < 2; ++i)
#pragma unroll
            for (int j = 0; j < 16; ++j) acc[i][j] = 0.f;
        const bf16_t* wp = wm + ((size_t)g * 128 + 32 * pb + r) * 128 + 8 * hh;
#pragma unroll
        for (int s = 0; s < 8; ++s) {
            const bf16x8 a = *(const GAS bf16x8*)(wp + 16 * s);
#pragma unroll
            for (int i = 0; i < 2; ++i) { const bf16x8 bq = *(const LAS bf16x8*)(xt + (32 * (cb0 + i) + r) * SG_XST + 16 * s + 8 * hh); acc[i] = MFMA32(a, bq, acc[i]); }
        }
#pragma unroll
        for (int i = 0; i < 2; ++i)
#pragma unroll
            for (int j = 0; j < 16; ++j) { const int p = 32 * pb + (j & 3) + 8 * (j >> 2) + 4 * hh; sl[p * SG_SST + 32 * (cb0 + i) + r] = acc[i][j] + *(const GAS float*)(bs + g * 128 + p); }
    }
    __syncthreads();
#pragma unroll
    for (int i = 0; i < 4; ++i) {
        const int p = (tid >> 4) + 32 * i, cg = tid & 15; const size_t tok = (size_t)(t0 + p);
        const f32x4 sa = *(const LAS f32x4*)(sl + p * SG_SST + 8 * cg), sb = *(const LAS f32x4*)(sl + p * SG_SST + 8 * cg + 4);
        const u32x4 w = *(const GAS u32x4*)(ug + tok * 1024 + g * 128 + 8 * cg);
        f32x4 oa, ob; oa[0] = gelu_t(bf_lo(w.x)) * sa[0]; oa[1] = gelu_t(bf_hi(w.x)) * sa[1]; oa[2] = gelu_t(bf_lo(w.y)) * sa[2]; oa[3] = gelu_t(bf_hi(w.y)) * sa[3];
        ob[0] = gelu_t(bf_lo(w.z)) * sb[0]; ob[1] = gelu_t(bf_hi(w.z)) * sb[1]; ob[2] = gelu_t(bf_lo(w.w)) * sb[2]; ob[3] = gelu_t(bf_hi(w.w)) * sb[3];
        *(GAS u32x4*)(ab + tok * D + 1024 + g * 128 + 8 * cg) = pack8(oa, ob);
    }
    __syncthreads();
}
__device__ __forceinline__ void phase_sgu(const Ctx& C0, unsigned char* ws, const float* lng, const float* lnb, const float* bs) {
    const Ctx C = fresh(C0);
    const bf16_t* ug = (const bf16_t*)ACT_TM(ws, C, A_UG, 1024); const bf16_t* vg = (const bf16_t*)ACT_TM(ws, C, A_VG, 1024); const float* psv = (const float*)(ws + WS_PSV);
    const bf16_t* wm = (const bf16_t*)(ws + WS_WMIX + WM_WS); bf16_t* ab = (bf16_t*)ACT_TM(ws, C, A_AB, D);
#pragma unroll 1
    for (int li = rank_of(C); li < 256; li += nper_of(C)) { const int it = grp_of(C) * 256 + li; sgu_unit(C, ug, vg, psv, wm, lng, lnb, bs, ab, it >> 3, it & 7); }
}

constexpr int RT_QST = 264, RT_TST = 72;
constexpr int RT_QS = 0, RT_KS = 64 * RT_QST * 2, RT_KT = 2 * RT_KS, RT_VT = RT_KT + 256 * RT_TST * 2, RT_PS = RT_VT + 128 * RT_TST * 2, RT_END = RT_PS + 64 * RT_TST * 2;
static_assert(RT_END <= LDS_MISC, "retention LDS");
__device__ __forceinline__ void ret_unit(const Ctx& C, const bf16_t* rq, const bf16_t* rk, bf16_t* rv, int b, int h, int dvq, bool do_store) {
    const int tid = C.tid, lane = C.lane, w8 = C.wave, lr = lane & 15, lg = lane >> 4;
    LAS bf16_t* Qs = (LAS bf16_t*)(C.lds + RT_QS); LAS bf16_t* Ks = (LAS bf16_t*)(C.lds + RT_KS); LAS bf16_t* KT = (LAS bf16_t*)(C.lds + RT_KT);
    LAS bf16_t* VT = (LAS bf16_t*)(C.lds + RT_VT); LAS bf16_t* Ps = (LAS bf16_t*)(C.lds + RT_PS);
    const float lg2 = h == 0 ? -4.5803689613e-02f : h == 1 ? -2.2720076500e-02f : h == 2 ? -1.1315313228e-02f : h == 3 ? -5.6465631411e-03f : h == 4 ? -2.8205190624e-03f : h == 5 ? -1.4095702547e-03f : h == 6 ? -7.0461297659e-04f : -3.5226347163e-04f;
    const float g64 = h == 0 ? 1.3108403248e-01f : h == 1 ? 3.6498652424e-01f : h == 2 ? 6.0534099144e-01f : h == 3 ? 7.7841960936e-01f : h == 4 ? 8.8238904203e-01f : h == 5 ? 9.3938437596e-01f : h == 6 ? 9.6922583743e-01f : 9.8449455892e-01f;
    f32x4 st[16];
#pragma unroll
    for (int i = 0; i < 16; ++i) st[i] = (f32x4){0.f, 0.f, 0.f, 0.f};
    const int tg1 = tid >> 5, cg1 = tid & 31;
    const int tg2 = tid & 15, cg2 = tid >> 4;
    float kd[4];
#pragma unroll
    for (int i = 0; i < 4; ++i) kd[i] = fexp2(lg2 * (float)(63 - (4 * tg2 + i)));
    const size_t tb = (size_t)b * SEQ;
    const bf16_t* qsrc = rq + (tb + 4 * tg1) * 2048 + h * 256 + 8 * cg1;
    const bf16_t* ksrc = rk + (tb + 4 * tg1) * 2048 + h * 256 + 8 * cg1;
    bf16_t* vbase = rv + tb * RV + h * 512 + dvq * 128;
    const bf16_t* vsrc = vbase + (size_t)(4 * tg2) * RV + 4 * cg2;
    const int qdst = (4 * tg1) * RT_QST + 32 * (cg1 >> 2) + 16 * (cg1 & 1) + 4 * ((cg1 >> 1) & 1);
    const int kpat = (4 * tg2) * RT_QST + 32 * (cg2 >> 2) + 16 * (cg2 & 1) + 4 * ((cg2 >> 1) & 1);
    u32x4 qr[4], kr[4]; u32x2 vr[4];
#define RT_LOAD(n) do { _Pragma("unroll") for (int i = 0; i < 4; ++i) { qr[i] = *(const GAS u32x4*)(qsrc + ((size_t)(n) * 64 + i) * 2048); kr[i] = *(const GAS u32x4*)(ksrc + ((size_t)(n) * 64 + i) * 2048); \
        vr[i] = *(const GAS u32x2*)(vsrc + ((size_t)(n) * 64 + i) * RV); } } while (0)
#define RT_STAGE() do { \
        _Pragma("unroll") for (int i = 0; i < 4; ++i) { \
            *(LAS u32x2*)(Qs + qdst + i * RT_QST) = (u32x2){qr[i].x, qr[i].y}; *(LAS u32x2*)(Qs + qdst + i * RT_QST + 8) = (u32x2){qr[i].z, qr[i].w}; \
            *(LAS u32x2*)(Ks + qdst + i * RT_QST) = (u32x2){kr[i].x, kr[i].y}; *(LAS u32x2*)(Ks + qdst + i * RT_QST + 8) = (u32x2){kr[i].z, kr[i].w}; } \
        _Pragma("unroll") for (int w = 0; w < 2; ++w) { \
            u32x2 lo, hi; lo.x = (vr[0][w] & 0xffffu) | (vr[1][w] << 16); lo.y = (vr[2][w] & 0xffffu) | (vr[3][w] << 16); \
            hi.x = (vr[0][w] >> 16) | (vr[1][w] & 0xffff0000u); hi.y = (vr[2][w] >> 16) | (vr[3][w] & 0xffff0000u); \
            *(LAS u32x2*)(VT + (4 * cg2 + 2 * w) * RT_TST + 4 * tg2) = lo; *(LAS u32x2*)(VT + (4 * cg2 + 2 * w + 1) * RT_TST + 4 * tg2) = hi; } \
    } while (0)
    RT_LOAD(0);
    RT_STAGE();
    __syncthreads();
#pragma unroll 1
    for (int n = 0; n < 32; ++n) {
        const bool more = n + 1 < 32;
        if (more) RT_LOAD(n + 1);
        {
            u32x2 pl[4], ph[4];
#pragma unroll
            for (int i = 0; i < 4; ++i) { pl[i] = *(const LAS u32x2*)(Ks + kpat + i * RT_QST); ph[i] = *(const LAS u32x2*)(Ks + kpat + i * RT_QST + 8); }
#pragma unroll
            for (int w = 0; w < 4; ++w) {
                const unsigned x0 = (w < 2) ? pl[0][w & 1] : ph[0][w & 1], x1 = (w < 2) ? pl[1][w & 1] : ph[1][w & 1], x2 = (w < 2) ? pl[2][w & 1] : ph[2][w & 1], x3 = (w < 2) ? pl[3][w & 1] : ph[3][w & 1];
                *(LAS u32x2*)(KT + (8 * cg2 + 2 * w) * RT_TST + 4 * tg2) = (u32x2){pk2(bf_lo(x0) * kd[0], bf_lo(x1) * kd[1]), pk2(bf_lo(x2) * kd[2], bf_lo(x3) * kd[3])};
                *(LAS u32x2*)(KT + (8 * cg2 + 2 * w + 1) * RT_TST + 4 * tg2) = (u32x2){pk2(bf_hi(x0) * kd[0], bf_hi(x1) * kd[1]), pk2(bf_hi(x2) * kd[2], bf_hi(x3) * kd[3])};
            }
            const int qi = w8 >> 1, ki0 = 2 * (w8 & 1);
            f32x4 pa[2] = {(f32x4){0.f, 0.f, 0.f, 0.f}, (f32x4){0.f, 0.f, 0.f, 0.f}};
            {
                const LAS bf16_t* qp = Qs + (16 * qi + lr) * RT_QST + 8 * lg; const LAS bf16_t* kp0 = Ks + (16 * ki0 + lr) * RT_QST + 8 * lg; const LAS bf16_t* kp1 = kp0 + 16 * RT_QST;
                bf16x8 fa[2], fb0[2], fb1[2];
#pragma unroll
                for (int s = 0; s < 2; ++s) { fa[s] = *(const LAS bf16x8*)(qp + 32 * s); fb0[s] = *(const LAS bf16x8*)(kp0 + 32 * s); fb1[s] = *(const LAS bf16x8*)(kp1 + 32 * s); }
#pragma unroll
                for (int s = 0; s < 8; ++s) {
                    pa[0] = MFMA16(fa[s & 1], fb0[s & 1], pa[0]); pa[1] = MFMA16(fa[s & 1], fb1[s & 1], pa[1]);
                    if (s + 2 < 8) { fa[s & 1] = *(const LAS bf16x8*)(qp + 32 * (s + 2)); fb0[s & 1] = *(const LAS bf16x8*)(kp0 + 32 * (s + 2)); fb1[s & 1] = *(const LAS bf16x8*)(kp1 + 32 * (s + 2)); }
                }
            }
#pragma unroll
            for (int j = 0; j < 2; ++j)
#pragma unroll
                for (int e = 0; e < 4; ++e) { const int iq = 16 * qi + 4 * lg + e, jk = 16 * (ki0 + j) + lr; const int dd = iq > jk ? iq - jk : jk - iq;
                    Ps[iq * RT_TST + jk] = (bf16_t)f2bf(pa[j][e] * fexp2(lg2 * (float)dd)); }
        }
        __syncthreads();
        f32x4 ot[4];
#pragma unroll
        for (int i = 0; i < 4; ++i) ot[i] = (f32x4){0.f, 0.f, 0.f, 0.f};
        {
            const LAS bf16_t* qp = Qs + lr * RT_QST + 8 * lg;
            bf16x8 bq[2][4];
#pragma unroll
            for (int tt = 0; tt < 4; ++tt) bq[0][tt] = *(const LAS bf16x8*)(qp + 16 * tt * RT_QST);
#pragma unroll
            for (int c = 0; c < 8; ++c) {
                if (c + 1 < 8) {
#pragma unroll
                    for (int tt = 0; tt < 4; ++tt) bq[(c + 1) & 1][tt] = *(const LAS bf16x8*)(qp + 16 * tt * RT_QST + 32 * (c + 1));
                }
                u32x4 sp; sp.x = pk2(st[2 * c][0], st[2 * c][1]); sp.y = pk2(st[2 * c][2], st[2 * c][3]); sp.z = pk2(st[2 * c + 1][0], st[2 * c + 1][1]); sp.w = pk2(st[2 * c + 1][2], st[2 * c + 1][3]);
                const bf16x8 sf = __builtin_bit_cast(bf16x8, sp);
#pragma unroll
                for (int tt = 0; tt < 4; ++tt) ot[tt] = MFMA16(sf, bq[c & 1][tt], ot[tt]);
            }
        }
#pragma unroll
        for (int tt = 0; tt < 4; ++tt) ot[tt] *= fexp2(lg2 * (float)(16 * tt + lr + 1));
        bf16x8 vt[2];
#pragma unroll
        for (int s = 0; s < 2; ++s) vt[s] = *(const LAS bf16x8*)(VT + (16 * w8 + lr) * RT_TST + 32 * s + 8 * lg);
        {
            bf16x8 bp[2][4];
#pragma unroll
            for (int s = 0; s < 2; ++s)
#pragma unroll
                for (int tt = 0; tt < 4; ++tt) bp[s][tt] = *(const LAS bf16x8*)(Ps + (16 * tt + lr) * RT_TST + 32 * s + 8 * lg);
#pragma unroll
            for (int s = 0; s < 2; ++s)
#pragma unroll
                for (int tt = 0; tt < 4; ++tt) ot[tt] = MFMA16(vt[s], bp[s][tt], ot[tt]);
        }
#pragma unroll
        for (int tt = 0; tt < 4; ++tt) if (do_store) *(GAS u32x2*)(vbase + (size_t)(n * 64 + 16 * tt + lr) * RV + 16 * w8 + 4 * lg) = (u32x2){pk2(ot[tt][0], ot[tt][1]), pk2(ot[tt][2], ot[tt][3])};
        {
            const LAS bf16_t* tp = KT + lr * RT_TST + 8 * lg;
            bf16x8 ka[3][2];
#pragma unroll
            for (int k = 0; k < 2; ++k)
#pragma unroll
                for (int s = 0; s < 2; ++s) ka[k][s] = *(const LAS bf16x8*)(tp + 16 * k * RT_TST + 32 * s);
#pragma unroll
            for (int kb = 0; kb < 16; ++kb) {
                if (kb + 2 < 16) {
#pragma unroll
                    for (int s = 0; s < 2; ++s) ka[(kb + 2) % 3][s] = *(const LAS bf16x8*)(tp + 16 * (kb + 2) * RT_TST + 32 * s);
                }
                st[kb] *= g64;
                st[kb] = MFMA16(ka[kb % 3][0], vt[0], st[kb]); st[kb] = MFMA16(ka[kb % 3][1], vt[1], st[kb]);
            }
        }
        __syncthreads();
        if (more) RT_STAGE();
        __syncthreads();
    }
#undef RT_LOAD
#undef RT_STAGE
}
__device__ __forceinline__ void phase_ret(const Ctx& C0, unsigned char* ws, bool do_store) {
    const Ctx C = fresh(C0);
    const bf16_t* rq = (const bf16_t*)ACT_TM(ws, C, A_RQ, 2048); const bf16_t* rk = (const bf16_t*)ACT_TM(ws, C, A_RK, 2048); bf16_t* rv = (bf16_t*)ACT_TM(ws, C, A_RVV, RV);
#pragma unroll 1
    for (int li = rank_of(C); li < 64; li += nper_of(C)) { const int it = grp_of(C) * 64 + (li ^ 32);         ret_unit(C, rq, rk, rv, it >> 5, (it >> 2) & 7, it & 3, do_store); }
}
__device__ __forceinline__ void phase_retnorm(const Ctx& C0, unsigned char* ws, const float* gng, const float* gnb, bool do_store = true) {
    const Ctx C = fresh(C0);
    bf16_t* rr = (bf16_t*)ACT_TM(ws, C, A_RVV, RV); const bf16_t* sg = (const bf16_t*)ACT_TM(ws, C, A_RSG, RV);
    const int gw = rank_of(C) * 8 + C.wave, NGW = nper_of(C) * 8, rbase = grp_of(C) * (4096 * 8);
    for (int lr0 = gw * 4; lr0 < 4096 * 8; lr0 += NGW * 4) { const int row0 = rbase + lr0;
        u32x4 w[4], gq[4];
#pragma unroll
        for (int k = 0; k < 4; ++k) { const size_t off = (size_t)(row0 + k) * 512 + 8 * C.lane; w[k] = __builtin_nontemporal_load((const GAS u32x4*)(rr + off)); gq[k] = __builtin_nontemporal_load((const GAS u32x4*)(sg + off)); }
#pragma unroll
        for (int k = 0; k < 4; ++k) {
            const int row = row0 + k, hd = row & 7; const size_t off = (size_t)row * 512 + 8 * C.lane;
            float x[8] = {bf_lo(w[k].x), bf_hi(w[k].x), bf_lo(w[k].y), bf_hi(w[k].y), bf_lo(w[k].z), bf_hi(w[k].z), bf_lo(w[k].w), bf_hi(w[k].w)};
            float s = 0.f;
#pragma unroll
            for (int i = 0; i < 8; ++i) s += x[i];
            const float mu = wave_sum(s) * (1.0f / 512.0f); float q = 0.f;
#pragma unroll
            for (int i = 0; i < 8; ++i) { x[i] -= mu; q += x[i] * x[i]; }
            const float rsd = rsqrtf(wave_sum(q) * (1.0f / 512.0f) + EPS);
            const int c0 = hd * 512 + 8 * C.lane;
            const f32x4 ga = *(const GAS f32x4*)(gng + c0), gb = *(const GAS f32x4*)(gng + c0 + 4), ba = *(const GAS f32x4*)(gnb + c0), bb = *(const GAS f32x4*)(gnb + c0 + 4);
            f32x4 oa, ob;
            float gg[8] = {bf_lo(gq[k].x), bf_hi(gq[k].x), bf_lo(gq[k].y), bf_hi(gq[k].y), bf_lo(gq[k].z), bf_hi(gq[k].z), bf_lo(gq[k].w), bf_hi(gq[k].w)};
#pragma unroll
            for (int i = 0; i < 8; ++i) gg[i] *= sigmoid_f(gg[i]);
            oa[0] = (x[0] * rsd * ga[0] + ba[0]) * gg[0]; oa[1] = (x[1] * rsd * ga[1] + ba[1]) * gg[1]; oa[2] = (x[2] * rsd * ga[2] + ba[2]) * gg[2]; oa[3] = (x[3] * rsd * ga[3] + ba[3]) * gg[3];
            ob[0] = (x[4] * rsd * gb[0] + bb[0]) * gg[4]; ob[1] = (x[5] * rsd * gb[1] + bb[1]) * gg[5]; ob[2] = (x[6] * rsd * gb[2] + bb[2]) * gg[6]; ob[3] = (x[7] * rsd * gb[3] + bb[3]) * gg[7];
            const u32x4 res_ = pack8(oa, ob); asm volatile("" :: "v"(res_)); if (do_store) *(GAS u32x4*)(rr + off) = res_;
        }
    }
}
__device__ __forceinline__ void phase_fixup(const Ctx& C0, unsigned char* ws, const float* cw3, const float* cb) {
    const Ctx C = fresh(C0);
    const float* side = (const float*)(ws + WS_SIDE); bf16_t* mo = (bf16_t*)ACT_TM(ws, C, A_M, FF);
    for (int li = rank_of(C) * 512 + C.tid; li < 16 * (FF / 4); li += nper_of(C) * 512) { const int i = grp_of(C) * (16 * (FF / 4)) + li;
        const int pm = i / (FF / 4), c = (i % (FF / 4)) * 4; const bool first = (pm & 7) == 0;
        f32x4 cv[2][2];
#pragma unroll
        for (int hv = 0; hv < 2; ++hv) {
            const int ch = hv * FF + c;
            const f32x4 z = {0.f, 0.f, 0.f, 0.f};
            const f32x4 am2 = first ? z : *(const GAS f32x4*)(side + ((size_t)(pm - 1) * 4 + 2) * FF2 + ch), am1 = first ? z : *(const GAS f32x4*)(side + ((size_t)(pm - 1) * 4 + 3) * FF2 + ch);
            const f32x4 a0 = *(const GAS f32x4*)(side + ((size_t)pm * 4 + 0) * FF2 + ch), a1 = *(const GAS f32x4*)(side + ((size_t)pm * 4 + 1) * FF2 + ch);
            const f32x4 w0 = *(const GAS f32x4*)(cw3 + ch), w1 = *(const GAS f32x4*)(cw3 + FF2 + ch), w2 = *(const GAS f32x4*)(cw3 + 2 * FF2 + ch), bb = *(const GAS f32x4*)(cb + ch);
            cv[hv][0] = bb + w0 * am2 + w1 * am1 + w2 * a0; cv[hv][1] = bb + w0 * am1 + w1 * a0 + w2 * a1;
        }
#pragma unroll
        for (int rw = 0; rw < 2; ++rw) { f32x4 g = cv[0][rw];
#pragma unroll
            for (int k = 0; k < 4; ++k) g[k] = gelu_t(g[k]) * cv[1][rw][k];
            *(GAS u32x2*)(mo + (size_t)(pm * 256 + rw) * FF + c) = (u32x2){pk2(g[0], g[1]), pk2(g[2], g[3])}; }
    }
}
__device__ __forceinline__ void phase_final(const Ctx& C0, float* out, const bf16_t* hb, const float* psh, const float* g) {
    const Ctx C = fresh(C0);
    const int gw = rank_of(C) * 8 + C.wave, NGW = nper_of(C) * 8;
    for (int lr = gw; lr < 4096; lr += NGW) { const int row = grp_of(C) * 4096 + lr;
        float s = C.lane < 8 ? *(const GAS float*)(psh + (size_t)row * 8 + C.lane) : 0.f; s = wave_sum(s);
        const float rsd = rsqrtf(s * (1.0f / D) + EPS); float* o = out + (size_t)row * D; const bf16_t* hr = hb + (size_t)row * D;
#pragma unroll
        for (int j = 0; j < 4; ++j) { const int c = j * 512 + 8 * C.lane; const u32x4 w = *(const GAS u32x4*)(hr + c); const f32x4 ga = *(const GAS f32x4*)(g + c), gb = *(const GAS f32x4*)(g + c + 4);
            f32x4 oa, ob; oa[0] = bf_lo(w.x); oa[1] = bf_hi(w.x); oa[2] = bf_lo(w.y); oa[3] = bf_hi(w.y); ob[0] = bf_lo(w.z); ob[1] = bf_hi(w.z); ob[2] = bf_lo(w.w); ob[3] = bf_hi(w.w);
            *(GAS f32x4*)(o + c) = oa * rsd * ga; *(GAS f32x4*)(o + c + 4) = ob * rsd * gb; }
    }
}

constexpr int NPHASE = 38;
struct Params { const void* in[27]; float* out; unsigned char* ws; int ph_lo, ph_hi; };
#define GEMM_PHASE(EPI, Aptr, Bptr, Mv, Nv, Kv, ...) do { pg8::Gemm g_{(const bf16_t*)(Aptr), (const bf16_t*)(Bptr), (Mv), (Nv), (Kv)}; pg8::StaticOrder S_; S_.init((Mv), (Nv), C.G, C.bid); \
        pg8::EPI E_{__VA_ARGS__}; pg8::gemm_phase<pg8::EPI, pg8::StaticOrder, true, true>((PG8_LAS unsigned char*)C.lds, g_, S_, E_, C.wave); } while (0)

template <class Tp> __device__ __forceinline__ Tp* opq(Tp* p) { asm volatile("" : "+s"(p)); return (Tp*)(GAS Tp*)p; }
#define SITE_VARS unsigned char* ws = opq(ws0); float* out = (float*)opq((unsigned char*)out0); unsigned char* act = ws + WS_ACT; (void)act; (void)out; \
    float* tabm = (float*)(ws + WS_TABM); float* tabr = (float*)(ws + WS_TABR); float* psq = (float*)(ws + WS_PSQ); float* pskv = (float*)(ws + WS_PSKV); float* psv = (float*)(ws + WS_PSV); (void)tabm; (void)tabr; (void)psq; (void)pskv; (void)psv; \
    bf16_t* hbc = (bf16_t*)(ws + (cur ? WS_HB1 : WS_HB0)); bf16_t* hbn = (bf16_t*)(ws + (cur ? WS_HB0 : WS_HB1)); float* psc = (float*)(ws + (cur ? WS_PSH1 : WS_PSH0)); float* psn = (float*)(ws + (cur ? WS_PSH0 : WS_PSH1)); (void)hbc; (void)hbn; (void)psc; (void)psn;
__global__ void __launch_bounds__(512, 2) fwd(Params P) {
    extern __shared__ __attribute__((aligned(16))) unsigned char lds_raw[];
    Ctx C; C.lds = (LAS unsigned char*)lds_raw; C.tid = threadIdx.x; C.lane = C.tid & 63; C.wave = __builtin_amdgcn_readfirstlane(C.tid >> 6); C.G = gridDim.x; C.bid = blockIdx.x;
    { const int t0_ = C.tid; C.tid = 0; C.lane = 0; if (t0_ < 64) ((volatile LAS unsigned*)(C.lds + LDS_MISC))[t0_] = 0u; }
    volatile LAS unsigned* misc = (volatile LAS unsigned*)(C.lds + LDS_MISC);
    __syncthreads();
    unsigned char* const ws0 = P.ws; float* const out0 = P.out;
    XcdBarrier bar; bar.bar = (unsigned*)(ws0 + WS_CTL) + CW_BAR; bar.x = 0; bar.st = misc;
#if MK_ONE_LAUNCH
    bar = xcd_barrier_post((unsigned*)(ws0 + WS_CTL) + CW_BAR, misc);
#endif
    const int lo = P.ph_lo, hi = P.ph_hi;
#ifndef SITE_ONLY
#define SITE_ONLY -1
#endif
#define SITE(n) (SITE_ONLY < 0 || SITE_ONLY == (n))
#define IN(k) (lo <= (k) && (k) < hi)
#define SEAM(k) do { if (IN(k) && IN((k) + 1)) xcd_barrier(bar); } while (0)
#define SEAM_L(k) do { if (IN(k) && IN((k) + 1)) { if (__builtin_amdgcn_readfirstlane((int)misc[3]) != 0) xcd_local_barrier(bar); else xcd_barrier(bar); } } while (0)
#define AP(OFF, W) ACT_TM(ws, C, OFF, W)

    enum { EV_D4 = 0, EV_D5, EV_D6, EV_D7, EV_D8, EV_RA, EV_RBC, EV_RDE };
#define LM() (__builtin_amdgcn_readfirstlane((int)misc[3]) != 0)
#define SEAM_S(k, s1, s2, rel) do { if (IN(k) && IN((k) + 1)) { if (LM()) xcd_local_barrier(bar, (s1), (s2), (rel)); else xcd_barrier(bar); } } while (0)
#define EV_WAIT(k, ev, tgt, acq) do { if (IN((k) - 1) && IN(k) && LM()) xcd_event_wait(bar, (ev), (unsigned)(tgt), (acq)); } while (0)
    int cur = 0;
    if constexpr (SITE(0)) if (IN(0)) { SITE_VARS
        phase_init(C, (const float*)(const GAS float*)P.in[0], (const int*)(const GAS int*)P.in[2], tabm, tabr, (bf16_t*)(ws + WS_HB0), (float*)(ws + WS_PSH0)); }
    if constexpr (SITE(1)) if (IN(1)) { SITE_VARS phase_prep(C, P.in, ws, 0, PREP_ALL, false); }
    SEAM(1);
#if MK_ONE_LAUNCH
    if (IN(1) && IN(2)) {
        if (LM()) C.bid = __builtin_amdgcn_readfirstlane((int)(misc[2] * 8u + bar.x));
    }
#endif
#pragma unroll 1
    for (int L = 0; L < DEPTH; ++L) {
        const int pb = 1 + 9 * L, j = L >> 1; const bool nxt = L + 1 < DEPTH;
        if (L >= 1) EV_WAIT(pb + 1, EV_RA, 8 * L, true);
        if ((L & 1) == 0) {
            if constexpr (SITE(2)) if (IN(pb + 1)) { SITE_VARS GEMM_PHASE(EpiE1, hbc, ws + WS_WMIX + WM_EIN, T, EINP, D, psc, (bf16_t*)AP(A_CQ, QL), (bf16_t*)AP(A_CKV, KVL), (bf16_t*)AP(A_KROT, 64), (bf16_t*)AP(A_UG, 1024), (bf16_t*)AP(A_VG, 1024), psq, pskv, psv, tabm, (PG8_LAS float*)(C.lds + LDS_XCH + 12288)); }
            SEAM_L(pb + 1);
            if constexpr (SITE(3)) if (IN(pb + 2)) { SITE_VARS
                GEMM_PHASE(EpiE2, AP(A_CQ, QL), ws + WS_WMIX + WM_QUP, T, QUPN, QL, psq, (bf16_t*)AP(A_Q, QUPN), tabm, (PG8_LAS float*)(C.lds + LDS_XCH + 12288));
                GEMM_PHASE(EpiE3k, AP(A_CKV, KVL), ws + WS_WMIX + WM_KVK, T, 1024, KVL, pskv, (bf16_t*)AP(A_KN, 1024), (PG8_LAS float*)(C.lds + LDS_XCH + 12288));
                GEMM_PHASE(EpiE3v, ws + WS_WMIX + WM_KVV, AP(A_CKV, KVL), 1024, T, KVL, pskv, (bf16_t*)ACT_VT(ws, C));
            }
            SEAM_L(pb + 2);
        } else {
            if constexpr (SITE(6)) if (IN(pb + 1)) { SITE_VARS GEMM_PHASE(EpiO1, hbc, ws + WS_WMIX + WM_RIN, T, RIN, D, psc, (bf16_t*)AP(A_RQ, 2048), (bf16_t*)AP(A_RK, 2048), (bf16_t*)AP(A_RVV, RV), (bf16_t*)AP(A_RSG, RV), tabr, (PG8_LAS float*)(C.lds + LDS_XCH + 12288)); }
            SEAM_L(pb + 1);
            if constexpr (SITE(7)) if (IN(pb + 2)) { SITE_VARS phase_ret(C, ws, true); }
            SEAM_L(pb + 2);
        }
        if (L >= 1) {
            EV_WAIT(pb + 3, EV_D7, 8 * L, false); EV_WAIT(pb + 3, EV_D8, 8 * L, false);
            if constexpr (SITE(1)) if (IN(pb + 3)) { SITE_VARS phase_prep(C, P.in, ws, L, PREP_FDN | PREP_PLEG, true); }
        }
        if ((L & 1) == 0) {
            if constexpr (SITE(4)) if (IN(pb + 3)) { SITE_VARS
                phase_attn(C, ws);
                phase_sgu(C, ws, (const float*)(const GAS float*)P.in[9] + (size_t)j * 1024, (const float*)(const GAS float*)P.in[10] + (size_t)j * 1024, (const float*)(const GAS float*)P.in[12] + (size_t)j * 1024);
            }
            SEAM_S(pb + 3, L >= 1 ? (int)EV_RDE : -1, -1, L >= 1);
            if constexpr (SITE(5)) if (IN(pb + 4)) { SITE_VARS GEMM_PHASE(EpiResid, AP(A_AB, D), ws + WS_WMIX + WM_EOUT, T, D, D, hbc, hbc, psc, (PG8_LAS float*)(C.lds + LDS_XCH)); }
        } else {
            if constexpr (SITE(8)) if (IN(pb + 3)) { SITE_VARS phase_retnorm(C, ws, (const float*)(const GAS float*)P.in[15] + (size_t)j * RV, (const float*)(const GAS float*)P.in[16] + (size_t)j * RV); }
            SEAM_S(pb + 3, L >= 1 ? (int)EV_RDE : -1, -1, L >= 1);
            if constexpr (SITE(9)) if (IN(pb + 4)) { SITE_VARS GEMM_PHASE(EpiResid, AP(A_RVV, RV), ws + WS_WMIX + WM_ROUT, T, D, RV, hbc, hbc, psc, (PG8_LAS float*)(C.lds + LDS_XCH)); }
        }
        SEAM_S(pb + 4, EV_D4, -1, false);
        if (L >= 1) EV_WAIT(pb + 5, EV_RBC, 8 * L, true);
        if constexpr (SITE(10)) if (IN(pb + 5)) { SITE_VARS
            GEMM_PHASE(EpiF1, hbc, ws + WS_WFFN + WF_UP, T, FF2, D, psc, (bf16_t*)AP(A_M, FF), (float*)(ws + WS_SIDE), (const float*)(const GAS float*)P.in[20] + (size_t)L * 3 * FF2, (const float*)(const GAS float*)P.in[21] + (size_t)L * FF2, (PG8_LAS float*)(C.lds + LDS_XCH)); }
        SEAM_S(pb + 5, EV_D5, -1, false);
        if (nxt) {
            EV_WAIT(pb + 6, EV_D4, 8 * (L + 1), false);
            if constexpr (SITE(1)) if (IN(pb + 6)) { SITE_VARS phase_prep(C, P.in, ws, L + 1, PREP_MIX, true); }
        }
        if constexpr (SITE(11)) if (IN(pb + 6)) { SITE_VARS
            phase_fixup(C, ws, (const float*)(const GAS float*)P.in[20] + (size_t)L * 3 * FF2, (const float*)(const GAS float*)P.in[21] + (size_t)L * FF2);
            GEMM_PHASE(EpiStore, ws + WS_PBF, ws + WS_WPLE + WP_U, T, D, PLE, (bf16_t*)AP(A_UPV, D), D);
        }
        SEAM_S(pb + 6, EV_D6, nxt ? (int)EV_RA : -1, nxt);
        if (L >= 1) EV_WAIT(pb + 7, EV_RDE, 8 * L, true);
        if constexpr (SITE(12)) if (IN(pb + 7)) { SITE_VARS GEMM_PHASE(EpiResid, AP(A_M, FF), ws + WS_WFFN + WF_DN, T, D, FF, hbc, hbc, psc, (PG8_LAS float*)(C.lds + LDS_XCH)); }
        SEAM_S(pb + 7, EV_D7, -1, false);
        if (nxt) {
            EV_WAIT(pb + 8, EV_D5, 8 * (L + 1), false); EV_WAIT(pb + 8, EV_D6, 8 * (L + 1), false);
            if constexpr (SITE(1)) if (IN(pb + 8)) { SITE_VARS phase_prep(C, P.in, ws, L + 1, PREP_FUP | PREP_PLEU, true); }
        }
        if constexpr (SITE(13)) if (IN(pb + 8)) { SITE_VARS GEMM_PHASE(EpiPle, hbc, ws + WS_WPLE + WP_G, T, D, D, hbc, (const bf16_t*)AP(A_UPV, D), hbn, psc, psn, (PG8_LAS float*)(C.lds + LDS_XCH), (PG8_LAS float*)(C.lds + LDS_XCH + 12288)); }
        SEAM_S(pb + 8, EV_D8, nxt ? (int)EV_RBC : -1, nxt);
        cur ^= 1;
    }
    if constexpr (SITE(14)) if (IN(NPHASE - 1)) { SITE_VARS phase_final(C, out, hbc, psc, (const float*)(const GAS float*)P.in[26]); }
#undef LM
#undef SEAM_S
#undef EV_WAIT
#undef IN
#undef SEAM
#undef SEAM_L
#undef AP
}

extern "C" void kernel_launch(void* const* d_in, const int* in_sizes, int n_in, void* d_out, int out_size, void* d_ws, size_t ws_size, hipStream_t stream) {
    static int grid = 0;
    if (grid == 0) {
        if (n_in != 27 || out_size != T * D || ws_size < WS_END) { fprintf(stderr, "kernel_launch: unexpected problem (n_in %d, out %d, ws %zu < %zu)\n", n_in, out_size, ws_size, (size_t)WS_END); grid = -1; return; }
        int dev = 0, cus = 0, per_cu = 0;
        if (hipGetDevice(&dev) != hipSuccess || hipDeviceGetAttribute(&cus, hipDeviceAttributeMultiprocessorCount, dev) != hipSuccess) { grid = -1; return; }
        if (hipFuncSetAttribute((const void*)fwd, hipFuncAttributeMaxDynamicSharedMemorySize, LDS_BYTES) != hipSuccess) { fprintf(stderr, "kernel_launch: hipFuncSetAttribute failed\n"); grid = -1; return; }
        if (hipOccupancyMaxActiveBlocksPerMultiprocessor(&per_cu, (const void*)fwd, 512, LDS_BYTES) != hipSuccess || per_cu < 1) fprintf(stderr, "kernel_launch: occupancy query says %d\n", per_cu);
        (void)hipGetLastError();
        grid = cus >= 8 ? cus - cus % 8 : 256;
    }
    if (grid < 0) return;
    if (hipMemsetAsync((char*)d_ws + WS_CTL, 0, CTL_ZERO_BYTES, stream) != hipSuccess) return;
    Params p{};
    for (int i = 0; i < 27; ++i) p.in[i] = d_in[i];
    p.out = (float*)d_out; p.ws = (unsigned char*)d_ws;
#if MK_ONE_LAUNCH
    p.ph_lo = 0; p.ph_hi = NPHASE;
    hipLaunchKernelGGL(fwd, dim3(grid), dim3(512), LDS_BYTES, stream, p);
#else
    for (int k = 0; k < NPHASE; ++k) { p.ph_lo = k; p.ph_hi = k + 1; hipLaunchKernelGGL(fwd, dim3(grid), dim3(512), LDS_BYTES, stream, p); }
#endif
    const hipError_t le = hipPeekAtLastError();
    if (le != hipSuccess) fprintf(stderr, "kernel_launch: launch failed: %s\n", hipGetErrorName(le));
}
```

```cpp
#include <hip/hip_runtime.h>
#include <cstdio>
#include <cstdint>

#ifndef MK_ONE_LAUNCH
#define MK_ONE_LAUNCH 1
#endif

#define LAS __attribute__((address_space(3)))
#define GAS __attribute__((address_space(1)))
typedef unsigned short bf16_t;
typedef short bf16x8 __attribute__((ext_vector_type(8)));
typedef float f32x4 __attribute__((ext_vector_type(4)));
typedef float f32x2 __attribute__((ext_vector_type(2)));
typedef float f32x16 __attribute__((ext_vector_type(16)));
typedef unsigned u32x4 __attribute__((ext_vector_type(4)));
typedef unsigned u32x2 __attribute__((ext_vector_type(2)));
typedef _Float16 f16v2 __attribute__((ext_vector_type(2)));

constexpr int NB = 16, SEQ = 2048, T = NB * SEQ, D = 2048, DEPTH = 4;
constexpr int QL = 512, KVL = 256, HM = 8, QKD = 192;
constexpr int EIN = 2880, EINP = 3072, QUPN = 1536;
constexpr int RIN = 12288, RV = 4096;
constexpr int FF = 5632, FF2 = 11264, PLE = 256;
constexpr float EPS = 1e-6f;

constexpr size_t MiB = 1u << 20;
constexpr size_t WS_CTL = 0, CTL_ZERO_BYTES = 65536;
constexpr size_t WS_TABM = 1 * MiB;
constexpr size_t WS_TABR = 9 * MiB;
constexpr size_t WS_PSH0 = 41 * MiB, WS_PSH1 = 45 * MiB;
constexpr size_t WS_PSQ = 49 * MiB;
constexpr size_t WS_PSKV = 50 * MiB;
constexpr size_t WS_PSV = 51 * MiB;
constexpr size_t WS_SIDE = 55 * MiB;
constexpr size_t WS_HB0 = 77 * MiB, WS_HB1 = 205 * MiB;
constexpr size_t WS_PBF = 333 * MiB;
constexpr size_t WS_WMIX = 349 * MiB;
constexpr size_t WS_WFFN = 413 * MiB;
constexpr size_t WS_WPLE = 479 * MiB;
constexpr size_t WS_ACT = 488 * MiB;
constexpr size_t WS_END = WS_ACT + 768 * MiB;
constexpr size_t WM_EIN = 0, WM_QUP = 12 * MiB, WM_KVK = 14 * MiB, WM_KVV = 15 * MiB, WM_EOUT = 16 * MiB, WM_WS = 24 * MiB;
constexpr size_t WM_RIN = 0, WM_ROUT = 48 * MiB;
constexpr size_t WF_UP = 0, WF_DN = 44 * MiB, WP_G = 0, WP_U = 8 * MiB;
constexpr size_t A_CQ = 0, A_CKV = 32 * MiB, A_KROT = 48 * MiB, A_UG = 52 * MiB, A_VG = 116 * MiB, A_Q = 180 * MiB, A_KN = 276 * MiB, A_VT = 340 * MiB, A_AB = 404 * MiB;
constexpr size_t A_RQ = 0, A_RK = 128 * MiB, A_RVV = 256 * MiB, A_RSG = 512 * MiB;
constexpr size_t A_M = 0, A_UPV = 384 * MiB;
constexpr int CW_BAR = 4096;
constexpr size_t SLAB = 96 * MiB;
constexpr int VTP = T / 8;

constexpr int LDS_BYTES = 163840;
constexpr int LDS_XCH = 131072;
constexpr int LDS_MISC = 163840 - 256;

#define LDS_WAIT() asm volatile("s_waitcnt lgkmcnt(0)" ::: "memory")
#define VM_WAIT() asm volatile("s_waitcnt vmcnt(0)" ::: "memory")
__device__ __forceinline__ unsigned f2bf(float f) { unsigned u = __float_as_uint(f); return (u + 0x7fffu + ((u >> 16) & 1u)) >> 16; }
typedef __bf16 bf16v2 __attribute__((ext_vector_type(2)));
__device__ __forceinline__ unsigned pk2(float lo, float hi) { const f32x2 v = {lo, hi}; return __builtin_bit_cast(unsigned, __builtin_convertvector(v, bf16v2)); }
__device__ __forceinline__ float bf_lo(unsigned w) { return __uint_as_float(w << 16); }
__device__ __forceinline__ float bf_hi(unsigned w) { return __uint_as_float(w & 0xffff0000u); }
__device__ __forceinline__ float fexp2(float x) { return __builtin_amdgcn_exp2f(x); }
__device__ __forceinline__ float frcp(float x) { return __builtin_amdgcn_rcpf(x); }
__device__ __forceinline__ float gelu_t(float x) { const float t = x * (-2.302208198f - 0.1029432397f * (x * x)); return x * frcp(1.0f + fexp2(t)); }
__device__ __forceinline__ float sigmoid_f(float x) { return frcp(1.0f + fexp2(-1.442695041f * x)); }
__device__ __forceinline__ float dot4(f32x4 a) { return (a[0] * a[0] + a[1] * a[1]) + (a[2] * a[2] + a[3] * a[3]); }
__device__ __forceinline__ float sum4(f32x4 a) { return (a[0] + a[1]) + (a[2] + a[3]); }
__device__ __forceinline__ u32x4 pack8(f32x4 a, f32x4 b) { u32x4 w; w.x = pk2(a[0], a[1]); w.y = pk2(a[2], a[3]); w.z = pk2(b[0], b[1]); w.w = pk2(b[2], b[3]); return w; }
template <int CTRL> __device__ __forceinline__ float dppf(float v) { return __int_as_float(__builtin_amdgcn_mov_dpp(__float_as_int(v), CTRL, 0xf, 0xf, true)); }
template <int CTRL> __device__ __forceinline__ f32x4 dpp4(f32x4 v) { f32x4 r; r[0] = dppf<CTRL>(v[0]); r[1] = dppf<CTRL>(v[1]); r[2] = dppf<CTRL>(v[2]); r[3] = dppf<CTRL>(v[3]); return r; }
__device__ __forceinline__ float wave_sum(float v) {
#pragma unroll
    for (int o = 1; o < 64; o <<= 1) v += __shfl_xor(v, o);
    return v;
}

__device__ __forceinline__ int lane_id_now() { int l; asm volatile("v_mbcnt_lo_u32_b32 %0, -1, 0\n\tv_mbcnt_hi_u32_b32 %0, -1, %0" : "=v"(l)); return l; }
namespace pg8 {
#define PG8_LAS __attribute__((address_space(3)))
typedef unsigned short bf16_t;
typedef short bf16x8 __attribute__((ext_vector_type(8)));
typedef float f32x4 __attribute__((ext_vector_type(4)));
typedef unsigned u32x4 __attribute__((ext_vector_type(4)));
constexpr int BM = 256, BK = 64, HALF = 128, HTB = HALF * BK * 2  , STAGE_BYTES = 8 * HTB, NXCD = 8, WGM = 8;

__host__ __device__ __forceinline__ int lds_byte(int r, int c) { const int st = (r >> 4) * 2 + (c >> 5), rr = r & 15, cc = c & 31, ob = rr * 64 + cc * 2; return st * 1024 + (ob ^ (((ob >> 9) & 1) << 5)); }
__host__ __device__ __forceinline__ void stage_rc(int b, int& R, int& C) { const int st = b / 1024, sb = b % 1024, swz = sb ^ (((sb >> 9) & 1) << 5); R = (st >> 1) * 16 + swz / 64; C = (st & 1) * 32 + (swz % 64) / 2; }
__host__ __device__ __forceinline__ int perm32(int rho) { const int n = rho >> 4, i = rho & 15; return 8 * (i >> 2) + 4 * n + (i & 3); }

struct Unit { int pm, pn; };
struct Gemm { const bf16_t* A; const bf16_t* Bt; int M, N, K; };

struct StaticOrder {
    int nM, nN, nwg, G, c;
    __host__ __device__ void init(int M, int N, int G_, int c_) { nM = M / BM; nN = N / BM; nwg = nM * nN; G = G_; c = c_; }
    __host__ __device__ bool next(int i, Unit& u) const {
        const long L = (long)i * G + c; if (L >= nwg) return false;
        int wgid = (int)L; { const int q = nwg / NXCD, r = nwg % NXCD, xcd = wgid % NXCD, off = wgid / NXCD; wgid = (xcd < r ? xcd * (q + 1) : r * (q + 1) + (xcd - r) * q) + off; }
        const int nig = WGM * nN, gid = wgid / nig, fm = gid * WGM, gsz = (nM - fm) < WGM ? (nM - fm) : WGM;
        u.pm = fm + ((wgid % nig) % gsz); u.pn = (wgid % nig) / gsz; return true;
    }
    __device__ __forceinline__ void a_ready(const Unit&) const {}
    __device__ __forceinline__ void done(const Unit&) const {}
};


#define EPI_FENCE() asm volatile("" ::: "memory")
#define EPI_ROWS(ai, m) _Pragma("unroll") for (int ai = 0; ai < 2; ++ai) _Pragma("unroll") for (int m = 0; m < 4; ++m)
template <int NP> __device__ __forceinline__ void load_rstd(const float* ps, int rowb, int fq, float inv_dim, float (&rs)[2][4]) {
    float s[2][4];
    EPI_ROWS(ai, m) {
        const float* p = ps + (size_t)(rowb + ai * 128 + m * 16) * NP + fq * (NP / 4);
        if constexpr (NP == 8) { const f32x2 a = *(const GAS f32x2*)p; s[ai][m] = a[0] + a[1]; } else s[ai][m] = *(const GAS float*)p;
    }
    EPI_ROWS(ai, m) { float t = s[ai][m]; t += __shfl_xor(t, 16); t += __shfl_xor(t, 32); rs[ai][m] = rsqrtf(t * inv_dim + EPS); }
}
template <int NP> __device__ __forceinline__ void ps_dma(const float* ps, PG8_LAS float* psl, const Unit& u, int wr, int wc, int fr, int fq) {
    const int wid = wr * 4 + wc, lane = fq * 16 + fr;
    if (NP == 8 || wid < 4) __builtin_amdgcn_global_load_lds((const unsigned*)(ps + (size_t)u.pm * BM * NP + (wid * 64 + lane) * 4), (PG8_LAS unsigned*)(psl + wid * 256), 16, 0, 0);
}
template <int NP> __device__ __forceinline__ void lds_rstd(const PG8_LAS float* psl, int wr, int fr, float inv_dim, float (&rs)[2][4]) {
    EPI_ROWS(ai, m) { const PG8_LAS float* p = psl + (ai * 128 + wr * 64 + m * 16 + fr) * NP; float t;
        if constexpr (NP == 8) { const f32x4 a = *(const PG8_LAS f32x4*)p, b = *(const PG8_LAS f32x4*)(p + 4); t = sum4(a) + sum4(b); } else { const f32x4 a = *(const PG8_LAS f32x4*)p; t = sum4(a); }
        rs[ai][m] = rsqrtf(t * inv_dim + EPS); }
}
struct NoPre {};
__device__ __forceinline__ void rope8(f32x4 t0, f32x4 t1, f32x4 t2, f32x4 t3, f32x4 x1a, f32x4 x1b, f32x4 x2a, f32x4 x2b, float sc, u32x4& o1, u32x4& o2) {
    x1a *= sc; x1b *= sc; x2a *= sc; x2b *= sc;
    f32x4 ra, rb, qa, qb;
    ra[0] = x1a[0] * t0[0] - x2a[0] * t0[1]; qa[0] = x2a[0] * t0[0] + x1a[0] * t0[1];
    ra[1] = x1a[1] * t0[2] - x2a[1] * t0[3]; qa[1] = x2a[1] * t0[2] + x1a[1] * t0[3];
    ra[2] = x1a[2] * t1[0] - x2a[2] * t1[1]; qa[2] = x2a[2] * t1[0] + x1a[2] * t1[1];
    ra[3] = x1a[3] * t1[2] - x2a[3] * t1[3]; qa[3] = x2a[3] * t1[2] + x1a[3] * t1[3];
    rb[0] = x1b[0] * t2[0] - x2b[0] * t2[1]; qb[0] = x2b[0] * t2[0] + x1b[0] * t2[1];
    rb[1] = x1b[1] * t2[2] - x2b[1] * t2[3]; qb[1] = x2b[1] * t2[2] + x1b[1] * t2[3];
    rb[2] = x1b[2] * t3[0] - x2b[2] * t3[1]; qb[2] = x2b[2] * t3[0] + x1b[2] * t3[1];
    rb[3] = x1b[3] * t3[2] - x2b[3] * t3[3]; qb[3] = x2b[3] * t3[2] + x1b[3] * t3[3];
    o1 = pack8(ra, rb); o2 = pack8(qa, qb);
}
__device__ __forceinline__ void row_ss_reduce(PG8_LAS float* red, float* ps, const float (&ss)[2][4], const Unit& u, int wr, int wc, int fr, int fq) {
    if (fq == 0) { EPI_ROWS(ai, m) red[(ai * HALF + wr * 64 + m * 16 + fr) * 4 + wc] = ss[ai][m]; }
    asm volatile("s_waitcnt lgkmcnt(0)" ::: "memory"); __builtin_amdgcn_s_barrier(); asm volatile("" ::: "memory");
    const int t = wr * 256 + wc * 64 + fq * 16 + fr;
    if (t < 256) { const f32x4 v = *(const PG8_LAS f32x4*)(red + t * 4); *(GAS float*)(ps + (size_t)(u.pm * BM + t) * 8 + u.pn) = sum4(v); }
}

__device__ __forceinline__ void unpack8(u32x4 w, f32x4& a, f32x4& b) { a[0] = bf_lo(w.x); a[1] = bf_hi(w.x); a[2] = bf_lo(w.y); a[3] = bf_hi(w.y); b[0] = bf_lo(w.z); b[1] = bf_hi(w.z); b[2] = bf_lo(w.w); b[3] = bf_hi(w.w); }
struct EpiResid {
    static constexpr bool PERM = true, AFTER_DRAIN = false;
    typedef NoPre Pre; __device__ __forceinline__ void prefetch(Pre&, const Unit&, int, int, int, int) const {}
    const bf16_t* hin; bf16_t* hb; float* ps; PG8_LAS float* red;
    __device__ __forceinline__ void operator()(f32x4 (&acc)[2][2][4][2], const Unit& u, int wr, int wc, int fr, int fq, const Pre& pre) const {
        asm volatile("" : "+v"(fr), "+v"(fq));
        const int row0 = u.pm * BM + wr * 64 + fr, col0 = u.pn * BM + wc * 32 + 8 * fq;
        float ssr[2][4];
#pragma unroll
        for (int ai = 0; ai < 2; ++ai) {
            u32x4 bv[4][2];
#pragma unroll
            for (int m = 0; m < 4; ++m)
#pragma unroll
                for (int bj = 0; bj < 2; ++bj) bv[m][bj] = *(const GAS u32x4*)(hin + (size_t)(row0 + ai * HALF + m * 16) * D + col0 + bj * HALF);
#pragma unroll
            for (int m = 0; m < 4; ++m) {
                const size_t off = (size_t)(row0 + ai * HALF + m * 16) * D + col0; float ss = 0.f;
#pragma unroll
                for (int bj = 0; bj < 2; ++bj) {
                    f32x4 b0, b1; unpack8(bv[m][bj], b0, b1);
                    const f32x4 v0 = acc[ai][bj][m][0] + b0, v1 = acc[ai][bj][m][1] + b1;
                    *(GAS u32x4*)(hb + off + bj * HALF) = pack8(v0, v1); ss += dot4(v0) + dot4(v1);
                }
                ss += __shfl_xor(ss, 16); ss += __shfl_xor(ss, 32); ssr[ai][m] = ss;
            }
            EPI_FENCE();
        }
        row_ss_reduce(red, ps, ssr, u, wr, wc, fr, fq);
    }
};
struct EpiPle {
    static constexpr bool PERM = true, AFTER_DRAIN = false;
    typedef NoPre Pre; __device__ __forceinline__ void prefetch(Pre&, const Unit& u, int wr, int wc, int fr, int fq) const { asm volatile("" : "+v"(fr), "+v"(fq)); ps_dma<8>(ps_in, psl, u, wr, wc, fr, fq); }
    const bf16_t* hin; const bf16_t* upv; bf16_t* hb; const float* ps_in; float* ps_out; PG8_LAS float* red; PG8_LAS float* psl;
    __device__ __forceinline__ void operator()(f32x4 (&acc)[2][2][4][2], const Unit& u, int wr, int wc, int fr, int fq, const Pre& pre) const {
        asm volatile("" : "+v"(fr), "+v"(fq));
        const int row0 = u.pm * BM + wr * 64 + fr, col0 = u.pn * BM + wc * 32 + 8 * fq;
        float rs[2][4]; lds_rstd<8>(psl, wr, fr, 1.0f / D, rs);
        float ssr[2][4];
#pragma unroll
        for (int ai = 0; ai < 2; ++ai) {
            u32x4 bv[4][2], uv[4][2];
#pragma unroll
            for (int m = 0; m < 4; ++m)
#pragma unroll
                for (int bj = 0; bj < 2; ++bj) { const size_t off = (size_t)(row0 + ai * HALF + m * 16) * D + col0 + bj * HALF; bv[m][bj] = *(const GAS u32x4*)(hin + off); uv[m][bj] = *(const GAS u32x4*)(upv + off); }
#pragma unroll
            for (int m = 0; m < 4; ++m) {
                const size_t off = (size_t)(row0 + ai * HALF + m * 16) * D + col0; float ss = 0.f; const float r = rs[ai][m];
#pragma unroll
                for (int bj = 0; bj < 2; ++bj) {
                    f32x4 v0, v1, u0, u1; unpack8(bv[m][bj], v0, v1); unpack8(uv[m][bj], u0, u1);
                    const f32x4 a0 = acc[ai][bj][m][0] * r, a1 = acc[ai][bj][m][1] * r;
#pragma unroll
                    for (int i = 0; i < 4; ++i) { v0[i] += u0[i] * sigmoid_f(a0[i]); v1[i] += u1[i] * sigmoid_f(a1[i]); }
                    *(GAS u32x4*)(hb + off + bj * HALF) = pack8(v0, v1); ss += dot4(v0) + dot4(v1);
                }
                ss += __shfl_xor(ss, 16); ss += __shfl_xor(ss, 32); ssr[ai][m] = ss;
            }
            EPI_FENCE();
        }
        row_ss_reduce(red, ps_out, ssr, u, wr, wc, fr, fq);
    }
};
struct EpiStore {
    static constexpr bool PERM = true, AFTER_DRAIN = false;
    typedef NoPre Pre; __device__ __forceinline__ void prefetch(Pre&, const Unit&, int, int, int, int) const {}
    bf16_t* o; int ldc;
    __device__ __forceinline__ void operator()(f32x4 (&acc)[2][2][4][2], const Unit& u, int wr, int wc, int fr, int fq, const Pre& pre) const {
        asm volatile("" : "+v"(fr), "+v"(fq));
        const int row0 = u.pm * BM + wr * 64 + fr, col0 = u.pn * BM + wc * 32 + 8 * fq;
        EPI_ROWS(ai, m) {
            const size_t off = (size_t)(row0 + ai * HALF + m * 16) * ldc + col0;
#pragma unroll
            for (int bj = 0; bj < 2; ++bj) *(GAS u32x4*)(o + off + bj * HALF) = pack8(acc[ai][bj][m][0], acc[ai][bj][m][1]);
        }
    }
};
__device__ __forceinline__ f32x4 h2x2_f32(unsigned w0, unsigned w1) { const f16v2 a = __builtin_bit_cast(f16v2, w0), b = __builtin_bit_cast(f16v2, w1); return (f32x4){(float)a[0], (float)a[1], (float)b[0], (float)b[1]}; }
template <bool TABH> __device__ __forceinline__ void rope_tile(f32x4 (&acc)[2][2][4][2], const float (&rs)[2][4], float sc, const float* tab, int tpitch, int tcol, bf16_t* d1, bf16_t* d2, size_t dpitch, int row0) {
#pragma unroll
    for (int ai = 0; ai < 2; ++ai)
#pragma unroll
        for (int mp = 0; mp < 2; ++mp) {
            f32x4 tv[2][4]; u32x4 tw[2][2];
#pragma unroll
            for (int mm = 0; mm < 2; ++mm) {
                if constexpr (TABH) { const GAS u32x4* tp = (const GAS u32x4*)((const unsigned*)tab + (size_t)(row0 + ai * HALF + (2 * mp + mm) * 16) * tpitch + tcol); tw[mm][0] = tp[0]; tw[mm][1] = tp[1]; }
                else { const GAS f32x4* tp = (const GAS f32x4*)(tab + ((size_t)(row0 + ai * HALF + (2 * mp + mm) * 16) * tpitch + tcol) * 2); tv[mm][0] = tp[0]; tv[mm][1] = tp[1]; tv[mm][2] = tp[2]; tv[mm][3] = tp[3]; }
            }
#pragma unroll
            for (int mm = 0; mm < 2; ++mm) { const int m = 2 * mp + mm; const size_t row = (size_t)(row0 + ai * HALF + m * 16); u32x4 o1, o2;
                if constexpr (TABH) { tv[mm][0] = h2x2_f32(tw[mm][0].x, tw[mm][0].y); tv[mm][1] = h2x2_f32(tw[mm][0].z, tw[mm][0].w); tv[mm][2] = h2x2_f32(tw[mm][1].x, tw[mm][1].y); tv[mm][3] = h2x2_f32(tw[mm][1].z, tw[mm][1].w); }
                rope8(tv[mm][0], tv[mm][1], tv[mm][2], tv[mm][3], acc[ai][0][m][0], acc[ai][0][m][1], acc[ai][1][m][0], acc[ai][1][m][1], rs[ai][m] * sc, o1, o2);
                *(GAS u32x4*)(d1 + row * dpitch) = o1; *(GAS u32x4*)(d2 + row * dpitch) = o2; }
            EPI_FENCE();
        }
}
struct EpiE1 {
    static constexpr bool PERM = true, AFTER_DRAIN = false;
    typedef NoPre Pre; __device__ __forceinline__ void prefetch(Pre&, const Unit& u, int wr, int wc, int fr, int fq) const { asm volatile("" : "+v"(fr), "+v"(fq)); ps_dma<8>(ps, psl, u, wr, wc, fr, fq); }
    const float* ps; bf16_t *cq, *ckv, *krot, *ug, *vg; float *psq, *pskv, *psv; const float* tabm; PG8_LAS float* psl;
    __device__ __forceinline__ void operator()(f32x4 (&acc)[2][2][4][2], const Unit& u, int wr, int wc, int fr, int fq, const Pre& pre) const {
        asm volatile("" : "+v"(fr), "+v"(fq));
        const int row0 = u.pm * BM + wr * 64 + fr, cw = wc * 32 + 8 * fq, pn = u.pn;
        float rs[2][4]; lds_rstd<8>(psl, wr, fr, 1.0f / D, rs);
        if (pn < 2) {
            EPI_ROWS(ai, m) {
                const int row = row0 + ai * HALF + m * 16; const float r = rs[ai][m]; float ss = 0.f;
#pragma unroll
                for (int bj = 0; bj < 2; ++bj) { const f32x4 v0 = acc[ai][bj][m][0] * r, v1 = acc[ai][bj][m][1] * r;
                    *(GAS u32x4*)(cq + (size_t)row * QL + pn * 256 + bj * HALF + cw) = pack8(v0, v1); ss += dot4(v0) + dot4(v1); }
                ss += __shfl_xor(ss, 16); ss += __shfl_xor(ss, 32);
                if (fq == 0) *(GAS float*)(psq + (size_t)row * 8 + pn * 4 + wc) = ss;
                EPI_FENCE();
            }
        } else if (pn == 2) {
            EPI_ROWS(ai, m) {
                const int row = row0 + ai * HALF + m * 16; const float r = rs[ai][m]; float ss = 0.f;
#pragma unroll
                for (int bj = 0; bj < 2; ++bj) { const f32x4 v0 = acc[ai][bj][m][0] * r, v1 = acc[ai][bj][m][1] * r;
                    *(GAS u32x4*)(ckv + (size_t)row * KVL + bj * HALF + cw) = pack8(v0, v1); ss += dot4(v0) + dot4(v1); }
                ss += __shfl_xor(ss, 16); ss += __shfl_xor(ss, 32);
                if (fq == 0) *(GAS float*)(pskv + (size_t)row * 4 + wc) = ss;
                EPI_FENCE();
            }
        } else if (pn < 11) {
            const bool isv = pn >= 7; bf16_t* dst = isv ? vg : ug; const int colt = (isv ? pn - 7 : pn - 3) * 256;
            EPI_ROWS(ai, m) {
                const int row = row0 + ai * HALF + m * 16; const float r = rs[ai][m]; float s1 = 0.f, s2 = 0.f;
#pragma unroll
                for (int bj = 0; bj < 2; ++bj) { f32x4 v0 = acc[ai][bj][m][0] * r, v1 = acc[ai][bj][m][1] * r;
                    if (isv) {
#pragma unroll
                        for (int i = 0; i < 4; ++i) { v0[i] = gelu_t(v0[i]); v1[i] = gelu_t(v1[i]); } }
                    *(GAS u32x4*)(dst + (size_t)row * 1024 + colt + bj * HALF + cw) = pack8(v0, v1); s1 += sum4(v0) + sum4(v1); s2 += dot4(v0) + dot4(v1); }
                if (isv) { s1 += __shfl_xor(s1, 16); s1 += __shfl_xor(s1, 32); s2 += __shfl_xor(s2, 16); s2 += __shfl_xor(s2, 32);
                    if (fq == 0) *(GAS f32x2*)(psv + ((size_t)row * 16 + (pn - 7) * 4 + wc) * 2) = (f32x2){s1, s2}; }
                EPI_FENCE();
            }
        } else if (wc == 0) {
            rope_tile<false>(acc, rs, 1.0f, tabm, 32, 8 * fq, krot + 8 * fq, krot + 32 + 8 * fq, 64, row0);
        }
    }
};
struct EpiE2 {
    static constexpr bool PERM = true, AFTER_DRAIN = false;
    typedef NoPre Pre; __device__ __forceinline__ void prefetch(Pre&, const Unit& u, int wr, int wc, int fr, int fq) const { asm volatile("" : "+v"(fr), "+v"(fq)); ps_dma<8>(ps, psl, u, wr, wc, fr, fq); }
    const float* ps; bf16_t* q; const float* tabm; PG8_LAS float* psl;
    __device__ __forceinline__ void operator()(f32x4 (&acc)[2][2][4][2], const Unit& u, int wr, int wc, int fr, int fq, const Pre& pre) const {
        asm volatile("" : "+v"(fr), "+v"(fq));
        const int row0 = u.pm * BM + wr * 64 + fr, pn = u.pn;
        float rs[2][4]; lds_rstd<8>(psl, wr, fr, 1.0f / QL, rs);
        constexpr float QSC = 0.10411754f;
        if (pn < 4) {
            EPI_ROWS(ai, m) { const int row = row0 + ai * HALF + m * 16; const float r = rs[ai][m] * QSC;
#pragma unroll
                for (int bj = 0; bj < 2; ++bj) *(GAS u32x4*)(q + (size_t)row * QUPN + (2 * pn + bj) * QKD + wc * 32 + 8 * fq) = pack8(acc[ai][bj][m][0] * r, acc[ai][bj][m][1] * r); }
        } else {
            bf16_t* d = q + (4 * (pn - 4) + wc) * QKD + 128 + 8 * fq;
            rope_tile<false>(acc, rs, QSC, tabm, 32, 8 * fq, d, d + 32, QUPN, row0);
        }
    }
};
struct EpiE3k {
    static constexpr bool PERM = true, AFTER_DRAIN = false;
    typedef NoPre Pre; __device__ __forceinline__ void prefetch(Pre&, const Unit& u, int wr, int wc, int fr, int fq) const { asm volatile("" : "+v"(fr), "+v"(fq)); ps_dma<4>(ps, psl, u, wr, wc, fr, fq); }
    const float* ps; bf16_t* kn; PG8_LAS float* psl;
    __device__ __forceinline__ void operator()(f32x4 (&acc)[2][2][4][2], const Unit& u, int wr, int wc, int fr, int fq, const Pre& pre) const {
        asm volatile("" : "+v"(fr), "+v"(fq));
        const int row0 = u.pm * BM + wr * 64 + fr;
        float rs[2][4]; lds_rstd<4>(psl, wr, fr, 1.0f / KVL, rs);
        EPI_ROWS(ai, m) { const int row = row0 + ai * HALF + m * 16; const float r = rs[ai][m];
#pragma unroll
            for (int bj = 0; bj < 2; ++bj) *(GAS u32x4*)(kn + (size_t)row * 1024 + (2 * u.pn + bj) * 128 + wc * 32 + 8 * fq) = pack8(acc[ai][bj][m][0] * r, acc[ai][bj][m][1] * r); }
    }
};
struct EpiE3v {
    static constexpr bool PERM = true, AFTER_DRAIN = false;
    typedef NoPre Pre; __device__ __forceinline__ void prefetch(Pre&, const Unit&, int, int, int, int) const {}
    const float* ps; bf16_t* vt;
    __device__ __forceinline__ void operator()(f32x4 (&acc)[2][2][4][2], const Unit& u, int wr, int wc, int fr, int fq, const Pre& pre) const {
        asm volatile("" : "+v"(fr), "+v"(fq));
        const int row0 = u.pm * BM + wr * 64 + fr, t0 = u.pn * BM + wc * 32 + 8 * fq;
        f32x4 cs[2][2];
#pragma unroll
        for (int bj = 0; bj < 2; ++bj)
#pragma unroll
            for (int n = 0; n < 2; ++n)
#pragma unroll
                for (int i = 0; i < 4; ++i) { const f32x4 p = *(const GAS f32x4*)(ps + (size_t)(t0 + bj * HALF + 4 * n + i) * 4); cs[bj][n][i] = rsqrtf(sum4(p) * (1.0f / KVL) + EPS); }
        EPI_ROWS(ai, m) { const int row = row0 + ai * HALF + m * 16;
#pragma unroll
            for (int bj = 0; bj < 2; ++bj) *(GAS u32x4*)(vt + (size_t)row * VTP + t0 + bj * HALF) = pack8(acc[ai][bj][m][0] * cs[bj][0], acc[ai][bj][m][1] * cs[bj][1]); }
    }
};
struct EpiO1 {
    static constexpr bool PERM = true, AFTER_DRAIN = false;
    typedef NoPre Pre; __device__ __forceinline__ void prefetch(Pre&, const Unit& u, int wr, int wc, int fr, int fq) const { asm volatile("" : "+v"(fr), "+v"(fq)); ps_dma<8>(ps, psl, u, wr, wc, fr, fq); }
    const float* ps; bf16_t *rq, *rk, *rv, *rsg; const float* tabr; PG8_LAS float* psl;
    __device__ __forceinline__ void operator()(f32x4 (&acc)[2][2][4][2], const Unit& u, int wr, int wc, int fr, int fq, const Pre& pre) const {
        asm volatile("" : "+v"(fr), "+v"(fq));
        const int row0 = u.pm * BM + wr * 64 + fr, cw = wc * 32 + 8 * fq, pn = u.pn;
        float rs[2][4]; lds_rstd<8>(psl, wr, fr, 1.0f / D, rs);
        if (pn < 16) {
            bf16_t* dst = (pn < 8 ? rq : rk) + (pn & 7) * 256 + cw;
            rope_tile<true>(acc, rs, pn < 8 ? 1.0f : 0.0625f, tabr, 128, cw, dst, dst + 128, 2048, row0);
        } else {
            bf16_t* dst = (pn < 32 ? rv + (pn - 16) * 256 : rsg + (pn - 32) * 256) + cw;
            EPI_ROWS(ai, m) { const int row = row0 + ai * HALF + m * 16; const float r = rs[ai][m];
#pragma unroll
                for (int bj = 0; bj < 2; ++bj) *(GAS u32x4*)(dst + (size_t)row * RV + bj * HALF) = pack8(acc[ai][bj][m][0] * r, acc[ai][bj][m][1] * r); }
        }
    }
};
struct EpiF1 {
    static constexpr bool PERM = true, AFTER_DRAIN = false;
    typedef NoPre Pre;
    __device__ __forceinline__ void prefetch(Pre&, const Unit& u, int wr, int wc, int fr, int fq) const { asm volatile("" : "+v"(fr), "+v"(fq));
        PG8_LAS float* psl = xl + 3072;
        ps_dma<8>(ps, psl, u, wr, wc, fr, fq);
        const int wid = wr * 4 + wc, lane = fq * 16 + fr;
        if (wid < 4) { const int c4 = lane * 4, wch = (c4 >> 7) * FF + u.pn * HALF + (c4 & 127);
            __builtin_amdgcn_global_load_lds((const unsigned*)((wid < 3 ? cw3 + wid * FF2 : cb) + wch), (PG8_LAS unsigned*)(xl + 2048 + wid * 256), 16, 0, 0); } }
    const float* ps; bf16_t* mo; float* side; const float* cw3; const float* cb; PG8_LAS float* xl;
    __device__ __forceinline__ void operator()(f32x4 (&acc)[2][2][4][2], const Unit& u, int wr, int wc, int fr, int fq, const Pre& pre) const {
        asm volatile("" : "+v"(fr), "+v"(fq));
        const int row0 = u.pm * BM + wr * 64 + fr, jc = wc * 32 + 8 * fq;
        PG8_LAS float* wl = xl + 2048;
        float rs[2][4]; lds_rstd<8>(xl + 3072, wr, fr, 1.0f / D, rs);
        EPI_ROWS(ai, m) { const float r = rs[ai][m];
#pragma unroll
            for (int bj = 0; bj < 2; ++bj) { acc[ai][bj][m][0] *= r; acc[ai][bj][m][1] *= r; } }
        EPI_FENCE();
        if (fr >= 14) {
#pragma unroll
            for (int ai = 0; ai < 2; ++ai)
#pragma unroll
                for (int bj = 0; bj < 2; ++bj)
#pragma unroll
                    for (int n = 0; n < 2; ++n) *(PG8_LAS f32x4*)(xl + ((ai * 2 + wr) * 2 + (fr - 14)) * 256 + bj * HALF + jc + 4 * n) = acc[ai][bj][3][n];
        }
        if (wr == 0 && fr < 2) {
#pragma unroll
            for (int bj = 0; bj < 2; ++bj)
#pragma unroll
                for (int n = 0; n < 2; ++n) *(GAS f32x4*)(side + ((size_t)(u.pm * 4 + fr)) * FF2 + bj * FF + u.pn * HALF + jc + 4 * n) = acc[0][bj][0][n];
        }
        if (wr == 1 && fr >= 14) {
#pragma unroll
            for (int bj = 0; bj < 2; ++bj)
#pragma unroll
                for (int n = 0; n < 2; ++n) *(GAS f32x4*)(side + ((size_t)(u.pm * 4 + 2 + fr - 14)) * FF2 + bj * FF + u.pn * HALF + jc + 4 * n) = acc[1][bj][3][n];
        }
        asm volatile("s_waitcnt lgkmcnt(0)" ::: "memory"); __builtin_amdgcn_s_barrier(); asm volatile("" ::: "memory");
#pragma unroll
        for (int bjj = 0; bjj < 2; ++bjj)
#pragma unroll
            for (int n = 0; n < 2; ++n) {
                const int bj = 1 - bjj;
                const int lc = bj * HALF + jc + 4 * n;
                const f32x4 w0 = *(const PG8_LAS f32x4*)(wl + lc), w1 = *(const PG8_LAS f32x4*)(wl + 256 + lc), w2 = *(const PG8_LAS f32x4*)(wl + 512 + lc), bb = *(const PG8_LAS f32x4*)(wl + 768 + lc);
                const float m1 = fr >= 1 ? 1.f : 0.f, m2 = fr >= 2 ? 1.f : 0.f;
                const f32x4 w1a = w1 * m1, w1b = w1 - w1a, w0a = w0 * m2, w0b = w0 - w0a;
#pragma unroll
                for (int ai = 0; ai < 2; ++ai) {
                    const int src = ai * 2 + wr - 1;
                    const int srcc = src < 0 ? 0 : src; const float hz = src < 0 ? 0.f : 1.f;
                    asm volatile("" : "+v"(acc[ai][bj][0][n]), "+v"(acc[ai][bj][1][n]), "+v"(acc[ai][bj][2][n]), "+v"(acc[ai][bj][3][n]));
#pragma unroll
                    for (int mm = 0; mm < 4; ++mm) {
                        const int m = 3 - mm;
                        const f32x4 cur = acc[ai][bj][m][n];
                        f32x4 r1p, r2p;
                        if (m > 0) { r1p = dpp4<0x121>(acc[ai][bj][m - 1][n]); r2p = dpp4<0x122>(acc[ai][bj][m - 1][n]); }
                        else { const f32x4 hm2 = *(const PG8_LAS f32x4*)(xl + (srcc * 2 + 0) * 256 + lc) * hz, hm1 = *(const PG8_LAS f32x4*)(xl + (srcc * 2 + 1) * 256 + lc) * hz; r1p = hm1; r2p = (fr == 0) ? hm2 : hm1; }
                        const f32x4 r1c = dpp4<0x121>(cur), r2c = dpp4<0x122>(cur);
                        acc[ai][bj][m][n] = bb + w2 * cur + w1a * r1c + w1b * r1p + w0a * r2c + w0b * r2p;
                    }
                }
                EPI_FENCE();
            }
        EPI_ROWS(ai, m) {
            const int row = row0 + ai * HALF + m * 16;
            f32x4 g0 = acc[ai][0][m][0], g1 = acc[ai][0][m][1];
#pragma unroll
            for (int i = 0; i < 4; ++i) { g0[i] = gelu_t(g0[i]) * acc[ai][1][m][0][i]; g1[i] = gelu_t(g1[i]) * acc[ai][1][m][1][i]; }
            *(GAS u32x4*)(mo + (size_t)row * FF + u.pn * HALF + jc) = pack8(g0, g1);
        }
    }
};
struct EpiNull {
    static constexpr bool PERM = true, AFTER_DRAIN = false;
    typedef NoPre Pre; __device__ __forceinline__ void prefetch(Pre&, const Unit&, int, int, int, int) const {}
    __device__ __forceinline__ void operator()(f32x4 (&acc)[2][2][4][2], const Unit& u, int wr, int wc, int fr, int fq, const Pre&) const {
        EPI_ROWS(ai, m) { asm volatile("" :: "v"(acc[ai][0][m][0]), "v"(acc[ai][0][m][1]), "v"(acc[ai][1][m][0]), "v"(acc[ai][1][m][1])); }
    }
};
#undef EPI_ROWS

template <class Epi, class Sched, bool ALIGN_EPI = false, bool SP2 = false>
__device__ __forceinline__ void gemm_phase(PG8_LAS unsigned char* lds, const Gemm g, const Sched& S, const Epi& E, int wave_id) {
    int tid_ = wave_id * 64 + lane_id_now();
    const int tid = tid_, wid = __builtin_amdgcn_readfirstlane(tid >> 6), lane = tid & 63, wr = wid >> 2, wc = wid & 3, fr = lane & 15, fq = lane >> 4;
    const int K = g.K, nt = K / BK;
    unsigned voffA[2], voffB[2];
#pragma unroll
    for (int i = 0; i < 2; ++i) { int R, C; stage_rc(tid * 16 + i * 8192, R, C); const int Rb = Epi::PERM ? ((R & ~31) + perm32(R & 31)) : R;
        voffA[i] = (unsigned)(R * K + C) * 2u; voffB[i] = (unsigned)(Rb * K + C) * 2u; }
    const size_t kstep = (size_t)(BK * 2);
    const size_t hstep = (size_t)HALF * K * 2;
    const size_t tstep = 2 * hstep;
    const unsigned ldsw = (unsigned)wid * 1024u;
    const int aoff = lds_byte(wr * 64 + fr, fq * 8), boff = lds_byte(wc * 32 + fr, fq * 8);
#define PG8_SA(b, h) (((b) * 2 + (h)) * HTB)
#define PG8_SB(b, h) ((4 + (b) * 2 + (h)) * HTB)
#define PG8_STAGE(bufoff, gbase, voff) do { _Pragma("unroll") for (int _i = 0; _i < 2; ++_i) \
        __builtin_amdgcn_global_load_lds((const unsigned*)((const char*)(gbase) + (voff)[_i]), (PG8_LAS unsigned*)(lds + (bufoff) + ldsw + _i * 8192), 16, 0, 0); } while (0)
#define PG8_LDA(dst, b, h) do { _Pragma("unroll") for (int m = 0; m < 4; ++m) _Pragma("unroll") for (int k = 0; k < 2; ++k) dst[m][k] = *(const PG8_LAS bf16x8*)(lds + PG8_SA(b, h) + aoff + m * 2048 + k * 1024); } while (0)
#define PG8_LDB(dst, b, h) do { _Pragma("unroll") for (int n = 0; n < 2; ++n) _Pragma("unroll") for (int k = 0; k < 2; ++k) dst[n][k] = *(const PG8_LAS bf16x8*)(lds + PG8_SB(b, h) + boff + n * 2048 + k * 1024); } while (0)
#define PG8_MMA(ai, bj, At, Bt) do { __builtin_amdgcn_s_setprio(1); _Pragma("unroll") for (int m = 0; m < 4; ++m) _Pragma("unroll") for (int n = 0; n < 2; ++n) _Pragma("unroll") for (int k = 0; k < 2; ++k) \
        acc[ai][bj][m][n] = __builtin_amdgcn_mfma_f32_16x16x32_bf16(Bt[n][k], At[m][k], acc[ai][bj][m][n], 0, 0, 0); __builtin_amdgcn_s_setprio(0); } while (0)
#define PG8_WAIT_V(n) asm volatile("s_waitcnt vmcnt(" #n ")" ::: "memory")
#define PG8_WAIT_L(n) asm volatile("s_waitcnt lgkmcnt(" #n ")" ::: "memory")
#define PG8_BAR __builtin_amdgcn_s_barrier()
#define PG8_SCHED __builtin_amdgcn_sched_barrier(0)
    Unit cur, nxt; int ui = 0; typename Epi::Pre pre;
    if (!S.next(0, cur)) return;
    f32x4 acc[2][2][4][2];
#pragma unroll
    for (int a = 0; a < 2; ++a)
#pragma unroll
        for (int b = 0; b < 2; ++b)
#pragma unroll
            for (int m = 0; m < 4; ++m)
#pragma unroll
                for (int n = 0; n < 2; ++n) acc[a][b][m][n] = (f32x4){0.f, 0.f, 0.f, 0.f};
    bf16x8 At[4][2], B0[2][2], B1[2][2];
    const char* cA = (const char*)g.A + (size_t)cur.pm * tstep; const char* cB = (const char*)g.Bt + (size_t)cur.pn * tstep;
    S.a_ready(cur);
    if constexpr (SP2) {
        PG8_STAGE(PG8_SB(0, 0), cB, voffB); PG8_STAGE(PG8_SB(0, 1), cB + hstep, voffB); PG8_STAGE(PG8_SA(0, 0), cA, voffA); PG8_STAGE(PG8_SA(0, 1), cA + hstep, voffA);
        if (wr == 1) PG8_BAR;
        PG8_WAIT_V(2); PG8_BAR;
        PG8_STAGE(PG8_SB(1, 0), cB + kstep, voffB); PG8_STAGE(PG8_SA(1, 0), cA + kstep, voffA); PG8_STAGE(PG8_SB(1, 1), cB + hstep + kstep, voffB);
        PG8_WAIT_V(6); PG8_BAR;
    } else {
        PG8_STAGE(PG8_SB(0, 0), cB, voffB); PG8_STAGE(PG8_SA(0, 0), cA, voffA); PG8_STAGE(PG8_SB(0, 1), cB + hstep, voffB); PG8_STAGE(PG8_SA(0, 1), cA + hstep, voffA);
        if (wr == 1) PG8_BAR;
        PG8_WAIT_V(4); PG8_BAR;
        PG8_STAGE(PG8_SB(1, 0), cB + kstep, voffB); PG8_STAGE(PG8_SA(1, 0), cA + kstep, voffA); PG8_STAGE(PG8_SB(1, 1), cB + hstep + kstep, voffB);
        PG8_WAIT_V(6); PG8_BAR;
    }
    for (;;) {
        const bool has_next = S.next(ui + 1, nxt);
        const char* nA = has_next ? (const char*)g.A + (size_t)nxt.pm * tstep : cA; const char* nB = has_next ? (const char*)g.Bt + (size_t)nxt.pn * tstep : cB;
#pragma unroll 1
        for (int t = 0; t < nt; t += 2) {
            const bool last = (t == nt - 2);
            const char* a1 = cA + (size_t)(t + 1) * kstep;
            const char* a2 = last ? nA : cA + (size_t)(t + 2) * kstep; const char* b2 = last ? nB : cB + (size_t)(t + 2) * kstep;
            const char* a3 = a2 + kstep; const char* b3 = b2 + kstep;
            if (last && has_next) S.a_ready(nxt);
            if (last) E.prefetch(pre, cur, wr, wc, fr, fq);
            if constexpr (SP2) {
            PG8_LDB(B0, 0, 0); PG8_LDB(B1, 0, 1); PG8_SCHED; PG8_LDA(At, 0, 0); PG8_STAGE(PG8_SA(1, 1), a1 + hstep, voffA);
            PG8_WAIT_V(8); PG8_WAIT_L(0); PG8_BAR; PG8_MMA(0, 0, At, B0); PG8_MMA(0, 1, At, B1); PG8_BAR; PG8_SCHED;
            PG8_LDA(At, 0, 1); PG8_STAGE(PG8_SB(0, 0), b2, voffB); PG8_STAGE(PG8_SB(0, 1), b2 + hstep, voffB); PG8_STAGE(PG8_SA(0, 0), a2, voffA);
            PG8_WAIT_V(8); PG8_WAIT_L(0); PG8_BAR; PG8_MMA(1, 0, At, B0); PG8_MMA(1, 1, At, B1); PG8_BAR; PG8_SCHED;
            PG8_LDB(B0, 1, 0); PG8_LDB(B1, 1, 1); PG8_SCHED; PG8_LDA(At, 1, 0); PG8_STAGE(PG8_SA(0, 1), a2 + hstep, voffA);
            PG8_WAIT_V(8); PG8_WAIT_L(0); PG8_BAR; PG8_MMA(0, 0, At, B0); PG8_MMA(0, 1, At, B1); PG8_BAR; PG8_SCHED;
            PG8_LDA(At, 1, 1); PG8_STAGE(PG8_SB(1, 0), b3, voffB); PG8_STAGE(PG8_SB(1, 1), b3 + hstep, voffB); PG8_STAGE(PG8_SA(1, 0), a3, voffA);
            PG8_WAIT_V(8); PG8_WAIT_L(0); PG8_BAR; PG8_MMA(1, 0, At, B0); PG8_MMA(1, 1, At, B1); PG8_BAR; PG8_SCHED;
            } else {
            PG8_LDB(B0, 0, 0); PG8_SCHED; PG8_LDA(At, 0, 0); PG8_STAGE(PG8_SA(1, 1), a1 + hstep, voffA);
            PG8_WAIT_L(8); PG8_BAR; PG8_WAIT_L(0); PG8_MMA(0, 0, At, B0); PG8_BAR; PG8_SCHED;
            PG8_LDB(B1, 0, 1); PG8_STAGE(PG8_SB(0, 0), b2, voffB);
            PG8_BAR; PG8_WAIT_L(0); PG8_MMA(0, 1, At, B1); PG8_BAR;
            PG8_LDA(At, 0, 1); PG8_STAGE(PG8_SA(0, 0), a2, voffA);
            PG8_BAR; PG8_WAIT_L(0); PG8_MMA(1, 0, At, B0); PG8_BAR; PG8_SCHED;
            PG8_STAGE(PG8_SB(0, 1), b2 + hstep, voffB);
            PG8_WAIT_V(6); PG8_BAR; PG8_MMA(1, 1, At, B1); PG8_BAR;
            PG8_LDB(B0, 1, 0); PG8_SCHED; PG8_LDA(At, 1, 0); PG8_STAGE(PG8_SA(0, 1), a2 + hstep, voffA);
            PG8_WAIT_L(8); PG8_BAR; PG8_WAIT_L(0); PG8_MMA(0, 0, At, B0); PG8_BAR; PG8_SCHED;
            PG8_LDB(B1, 1, 1); PG8_STAGE(PG8_SB(1, 0), b3, voffB);
            PG8_BAR; PG8_WAIT_L(0); PG8_MMA(0, 1, At, B1); PG8_BAR;
            PG8_LDA(At, 1, 1); PG8_STAGE(PG8_SA(1, 0), a3, voffA);
            PG8_BAR; PG8_WAIT_L(0); PG8_MMA(1, 0, At, B0); PG8_BAR; PG8_SCHED;
            PG8_STAGE(PG8_SB(1, 1), b3 + hstep, voffB);
            PG8_WAIT_V(6); PG8_BAR; PG8_MMA(1, 1, At, B1); PG8_BAR;
            }
        }
        if constexpr (ALIGN_EPI) { if (wr == 0) PG8_BAR; }
        if constexpr (!Epi::AFTER_DRAIN) { E(acc, cur, wr, wc, fr, fq, pre); S.done(cur); }
        if (!has_next) break;
#pragma unroll
        for (int a = 0; a < 2; ++a)
#pragma unroll
            for (int b = 0; b < 2; ++b)
#pragma unroll
                for (int m = 0; m < 4; ++m)
#pragma unroll
                    for (int n = 0; n < 2; ++n) acc[a][b][m][n] = (f32x4){0.f, 0.f, 0.f, 0.f};
        cur = nxt; cA = nA; cB = nB; ++ui;
        if constexpr (ALIGN_EPI) { if (wr == 1) PG8_BAR; }
    }
    PG8_WAIT_V(0);
    if constexpr (!ALIGN_EPI) { if (wr == 0) PG8_BAR; }
    PG8_BAR;
    if constexpr (Epi::AFTER_DRAIN) { E.fused(acc, cur, wr, wc, fr, fq, lds, wid, lane); S.done(cur); }
#undef PG8_SA
#undef PG8_SB
#undef PG8_STAGE
#undef PG8_LDA
#undef PG8_LDB
#undef PG8_MMA
#undef PG8_WAIT_V
#undef PG8_WAIT_L
#undef PG8_BAR
#undef PG8_SCHED
}
}

#define XB_TMO      128
#define XB_XCNT(j)  (256  + 64 * (j))
#define XB_XSUB(j)  (1280 + 64 * (j))
#define XB_XGEN(j)  (2304 + 64 * (j))
#define XB_TOP      3328
#define XB_TOPGEN   3392
#define XB_LSUB(j)  (3456 + 64 * (j))
#define XB_LGEN(j)  (4480 + 64 * (j))
#define XB_EV(i)    (5504 + 64 * (i))
#define XCD_BAR_WORDS 6528
#define XB_SPIN_CAP (1u << 18)

__device__ __forceinline__ unsigned xb_ld(unsigned* p)              { return __hip_atomic_load(p, __ATOMIC_RELAXED, __HIP_MEMORY_SCOPE_AGENT); }
__device__ __forceinline__ unsigned xb_add(unsigned* p, unsigned v) { return __hip_atomic_fetch_add(p, v, __ATOMIC_RELAXED, __HIP_MEMORY_SCOPE_AGENT); }
__device__ __forceinline__ unsigned xb_xcc_id() { return (unsigned)__builtin_amdgcn_s_getreg((3 << 11) | 20) & 0xFu; }
#define XB_SPIN(cond, bar) do { unsigned _sp = 0; while (cond) { __builtin_amdgcn_s_sleep(1); \
    if ((++_sp & 255u) == 0u) { if (xb_ld(&(bar)[XB_TMO])) break; if (_sp > XB_SPIN_CAP) { atomicAdd(&(bar)[XB_TMO], 1u); break; } } } } while (0)

struct XcdBarrier {
    unsigned* bar; unsigned x;
    volatile LAS unsigned* st;
};

__device__ __forceinline__ XcdBarrier xcd_barrier_post(unsigned* bar, volatile LAS unsigned* st) {
    XcdBarrier b; b.bar = bar; b.x = xb_xcc_id(); b.st = st;
    if (threadIdx.x == 0) st[2] = xb_add(&bar[XB_XCNT(b.x)], 1u);
    return b;
}
__device__ __forceinline__ void xcd_barrier_complete(unsigned* bar, unsigned x, unsigned& nloc, unsigned& nx, unsigned& even8) {
    const unsigned G = gridDim.x * gridDim.y * gridDim.z;
    unsigned sum, cnt, mine, bad, sp = 0u;
    for (;;) {
        sum = 0u; cnt = 0u; mine = 0u; bad = 0u;
#pragma unroll
        for (unsigned j = 0; j < 16; ++j) { const unsigned c = xb_ld(&bar[XB_XCNT(j)]); sum += c; cnt += (c > 0u) ? 1u : 0u; mine = (j == x) ? c : mine; bad |= (j < 8u) ? (c * 8u != G) : (c != 0u); }
        if (sum == G) break;
        __builtin_amdgcn_s_sleep(1);
        if ((++sp & 255u) == 0u) { if (xb_ld(&bar[XB_TMO])) break; if (sp > XB_SPIN_CAP) { atomicAdd(&bar[XB_TMO], 1u); break; } }
    }
    nloc = mine > 0u ? mine : 1u; nx = cnt > 0u ? cnt : 1u;
    even8 = (sum == G && bad == 0u) ? 1u : 0u;
}

__device__ __forceinline__ void xcd_barrier(const XcdBarrier& b) {
    asm volatile("s_waitcnt vmcnt(0)" ::: "memory");
    __syncthreads();
    if (threadIdx.x == 0) {
        unsigned* bar = b.bar;
        __builtin_amdgcn_s_waitcnt(0);
        unsigned nloc = b.st[0], nx = b.st[1];
        if (nloc == 0u) { unsigned e8; xcd_barrier_complete(bar, b.x, nloc, nx, e8); b.st[0] = nloc; b.st[1] = nx; b.st[3] = e8; }
        const unsigned old = xb_add(&bar[XB_XSUB(b.x)], 1u);
        const unsigned gen = old / nloc;
        if (old + 1u == (gen + 1u) * nloc) {
            __builtin_amdgcn_fence(__ATOMIC_RELEASE, "agent");
            asm volatile("s_waitcnt vmcnt(0)" ::: "memory");
            const unsigned og = xb_add(&bar[XB_TOP], 1u);
            const unsigned tg = og / nx;
            if (og + 1u == (tg + 1u) * nx) xb_add(&bar[XB_TOPGEN], 1u);
            else XB_SPIN(xb_ld(&bar[XB_TOPGEN]) == tg, bar);
            __builtin_amdgcn_fence(__ATOMIC_ACQUIRE, "agent");
            xb_add(&bar[XB_XGEN(b.x)], 1u);
            asm volatile("s_waitcnt vmcnt(0)" ::: "memory");
        } else {
            XB_SPIN(xb_ld(&bar[XB_XGEN(b.x)]) == gen, bar);
            __builtin_amdgcn_fence(__ATOMIC_ACQUIRE, "agent");
            asm volatile("s_waitcnt vmcnt(0)" ::: "memory");
        }
    }
    __syncthreads();
}

__device__ __forceinline__ void xcd_local_barrier(const XcdBarrier& b, int sig1 = -1, int sig2 = -1, bool rel = false) {
    asm volatile("s_waitcnt vmcnt(0)" ::: "memory");
    __syncthreads();
    if (threadIdx.x == 0) {
        unsigned* bar = b.bar;
        __builtin_amdgcn_s_waitcnt(0);
        const unsigned nloc = b.st[0];
        const unsigned old = xb_add(&bar[XB_LSUB(b.x)], 1u);
        const unsigned gen = old / nloc;
        if (old + 1u == (gen + 1u) * nloc) {
            if (rel) { __builtin_amdgcn_fence(__ATOMIC_RELEASE, "agent"); asm volatile("s_waitcnt vmcnt(0)" ::: "memory"); }
            if (sig1 >= 0) xb_add(&bar[XB_EV(sig1)], 1u);
            if (sig2 >= 0) xb_add(&bar[XB_EV(sig2)], 1u);
            xb_add(&bar[XB_LGEN(b.x)], 1u);
        } else XB_SPIN(xb_ld(&bar[XB_LGEN(b.x)]) == gen, bar);
        __builtin_amdgcn_fence(__ATOMIC_ACQUIRE, "agent");
        asm volatile("s_waitcnt vmcnt(0)" ::: "memory");
    }
    __syncthreads();
}

__device__ __forceinline__ void xcd_event_wait(const XcdBarrier& b, int ev, unsigned target, bool acq) {
    if (threadIdx.x == 0) {
        unsigned* bar = b.bar;
        XB_SPIN(xb_ld(&bar[XB_EV(ev)]) < target, bar);
        if (acq) { __builtin_amdgcn_fence(__ATOMIC_ACQUIRE, "agent"); asm volatile("s_waitcnt vmcnt(0)" ::: "memory"); }
    }
    __syncthreads();
}

struct Ctx { LAS unsigned char* lds; int tid, lane, wave, G, bid; };
__device__ __forceinline__ Ctx fresh(const Ctx& C) { Ctx R = C; const int t = C.wave * 64 + lane_id_now(); R.tid = t; R.lane = t & 63; return R; }
__device__ __forceinline__ int grp_of(const Ctx& C) { return C.bid & 7; }
__device__ __forceinline__ int rank_of(const Ctx& C) { return C.bid >> 3; }
__device__ __forceinline__ int nper_of(const Ctx& C) { return C.G >> 3; }
__device__ __forceinline__ unsigned char* actp(unsigned char* ws, const Ctx& C, size_t off, size_t shift) { return ws + WS_ACT + off / 8 + (size_t)(C.bid & 7) * (SLAB - shift); }
#define ACT_TM(ws, C, OFF, W) actp((ws), (C), (OFF), (size_t)4096 * (W) * 2)
#define ACT_VT(ws, C) actp((ws), (C), A_VT, (size_t)4096 * 2)

enum MapKind { MK_ID = 0, MK_EIN, MK_QUP, MK_KVK, MK_KVV, MK_FUP };
__device__ __forceinline__ int map_col(int kind, int rho0) {
    switch (kind) {
    case MK_EIN: { if (rho0 < 768) return rho0; if (rho0 < 2816) return rho0 + 64; const int q = rho0 - 2816, bj = q >> 7, jj = q & 127; return jj < 32 ? 768 + 32 * bj + jj : -1; }
    case MK_QUP: { const int pn = rho0 >> 8, q = rho0 & 255, bj = q >> 7, jj = q & 127; if (pn < 4) return (2 * pn + bj) * QKD + jj; return (4 * (pn - 4) + (jj >> 5)) * QKD + 128 + 32 * bj; }
    case MK_KVK: return (rho0 >> 7) * 256 + (rho0 & 127);
    case MK_KVV: return (rho0 >> 7) * 256 + 128 + (rho0 & 127);
    case MK_FUP: { const int pn = rho0 >> 8, q = rho0 & 255; return (q >> 7) * FF + pn * 128 + (q & 127); }
    default: return rho0;
    }
}
__device__ __forceinline__ void tr_item(const float* W, int Nsrc, int K, const float* gain, int kind, bf16_t* WT, int nblk, int item, LAS float* scr, int lane) {
    const int kb = item / nblk, nb = item % nblk, k0 = 64 * kb, rho0 = 32 * nb, sc0 = map_col(kind, rho0);
    if (sc0 >= 0) {
        float v[32];
        const GAS float* wp = (const GAS float*)(W + (size_t)(k0 + (lane >> 5)) * Nsrc + sc0 + (lane & 31));
#pragma unroll
        for (int i = 0; i < 32; ++i) v[i] = __builtin_nontemporal_load(wp + (size_t)(2 * i) * Nsrc);
        if (gain) { const GAS float* gp = (const GAS float*)(gain + k0 + (lane >> 5));
#pragma unroll
            for (int i = 0; i < 32; ++i) v[i] *= gp[2 * i]; }
#pragma unroll
        for (int i = 0; i < 32; ++i) scr[(2 * i + (lane >> 5)) * 33 + (lane & 31)] = v[i];
    } else {
#pragma unroll 8
        for (int i = 0; i < 32; ++i) { const int kk = 2 * i + (lane >> 5); scr[kk * 33 + (lane & 31)] = 0.f; }
    }
    LDS_WAIT();
    const int c = lane & 7;
#pragma unroll
    for (int j = 0; j < 4; ++j) { const int n = (lane >> 3) + 8 * j; const LAS float* s = scr + (8 * c) * 33 + n;
        u32x4 o; o.x = pk2(s[0 * 33], s[1 * 33]); o.y = pk2(s[2 * 33], s[3 * 33]); o.z = pk2(s[4 * 33], s[5 * 33]); o.w = pk2(s[6 * 33], s[7 * 33]);
        *(GAS u32x4*)(WT + (size_t)(rho0 + n) * K + k0 + 8 * c) = o; }
    LDS_WAIT();
}
__device__ __forceinline__ void tr_job(const Ctx& C, const float* W, const float* gain, bf16_t* WT, int Nsrc, int K, int Nout, int kind, int& base, unsigned* ctr) {
    LAS float* scr = (LAS float*)(C.lds + C.wave * 16384);
    const int nblk = Nout / 32, nit = (K / 64) * nblk;
    if (ctr) {
        volatile LAS unsigned* slot = (volatile LAS unsigned*)(C.lds + LDS_MISC + 64);
        for (;;) {
            if (C.tid == 0) *slot = __hip_atomic_fetch_add(ctr, 32u, __ATOMIC_RELAXED, __HIP_MEMORY_SCOPE_AGENT);
            __syncthreads();
            const int b = (int)*slot;
            __syncthreads();
            if (b >= nit) break;
#pragma unroll 1
            for (int q = 0; q < 4; ++q) { const int it = b + q * 8 + C.wave; if (it < nit) tr_item(W, Nsrc, K, gain, kind, WT, nblk, it, scr, C.lane); }
        }
    } else {
        const int gw = C.bid * 8 + C.wave, NGW = C.G * 8;
        int it = gw - (base % NGW); if (it < 0) it += NGW;
        for (; it < nit; it += NGW) tr_item(W, Nsrc, K, gain, kind, WT, nblk, it, scr, C.lane);
        base += nit;
    }
}
__device__ __forceinline__ void cvt_rows(const Ctx& C, const float* src, bf16_t* dst, size_t n) {
    const size_t stride = (size_t)C.G * 512 * 8;
    for (size_t i = ((size_t)C.bid * 512 + C.tid) * 8; i < n; i += stride) { const f32x4 a = *(const GAS f32x4*)(src + i), b = *(const GAS f32x4*)(src + i + 4); *(GAS u32x4*)(dst + i) = pack8(a, b); }
}

__device__ __forceinline__ void phase_init(const Ctx& C0, const float* x, const int* pos, float* tabm, float* tabr, bf16_t* hb, float* psh) {
    const Ctx C = fresh(C0);
    const size_t gt = (size_t)C.bid * 512 + C.tid, NT = (size_t)C.G * 512;
    for (size_t i = gt; i < (size_t)T * 32; i += NT) { const int t = (int)(i >> 5), j = (int)(i & 31); const float inv = powf(10000.0f, -(float)j / 32.0f), ang = (float)*(const GAS int*)(pos + t) * inv; float sn, cs; sincosf(ang, &sn, &cs); *(GAS f32x2*)(tabm + i * 2) = (f32x2){cs, sn}; }
    for (size_t i = gt; i < (size_t)T * 128; i += NT) { const int t = (int)(i >> 7), j = (int)(i & 127); const float inv = powf(10000.0f, -(float)j / 128.0f), ang = (float)*(const GAS int*)(pos + t) * inv; float sn, cs; sincosf(ang, &sn, &cs); const f16v2 hv = {(_Float16)cs, (_Float16)sn}; *(GAS unsigned*)((unsigned*)tabr + i) = __builtin_bit_cast(unsigned, hv); }
    const int gw = C.bid * 8 + C.wave, NGW = C.G * 8;
    for (int row = gw; row < T; row += NGW) {
        const float* xr = x + (size_t)row * D; float ss = 0.f;
#pragma unroll
        for (int j = 0; j < 4; ++j) { const int c = j * 512 + C.lane * 8; const f32x4 a = *(const GAS f32x4*)(xr + c), b = *(const GAS f32x4*)(xr + c + 4); *(GAS u32x4*)(hb + (size_t)row * D + c) = pack8(a, b); ss += dot4(a) + dot4(b); }
        ss = wave_sum(ss);
        if (C.lane < 8) *(GAS float*)(psh + (size_t)row * 8 + C.lane) = C.lane == 0 ? ss : 0.f;
    }
}

enum { PREP_MIX = 1, PREP_FUP = 2, PREP_PLEU = 4, PREP_FDN = 8, PREP_PLEG = 16, PREP_ALL = 31 };
__device__ __forceinline__ void phase_prep(const Ctx& C0, const void* const* in, unsigned char* ws, int L, int mask, bool dyn) {
    const Ctx C = fresh(C0);
    const int j = L >> 1; int base = 0;
    unsigned* const cq = dyn ? (unsigned*)(ws + WS_CTL) + 1024 + L * 16 : nullptr;
#define CQ(i) (dyn ? cq + (i) : nullptr)
    const float* mixg = (const float*)(const GAS float*)in[3] + (size_t)L * D;
    if (mask & PREP_MIX) {
    if ((L & 1) == 0) {
        tr_job(C, (const float*)(const GAS float*)in[4] + (size_t)j * D * EIN, mixg, (bf16_t*)(ws + WS_WMIX + WM_EIN), EIN, D, EINP, MK_EIN, base, CQ(0));
        tr_job(C, (const float*)(const GAS float*)in[6] + (size_t)j * QL * QUPN, (const float*)(const GAS float*)in[5] + (size_t)j * QL, (bf16_t*)(ws + WS_WMIX + WM_QUP), QUPN, QL, QUPN, MK_QUP, base, CQ(1));
        tr_job(C, (const float*)(const GAS float*)in[8] + (size_t)j * KVL * 2048, (const float*)(const GAS float*)in[7] + (size_t)j * KVL, (bf16_t*)(ws + WS_WMIX + WM_KVK), 2048, KVL, 1024, MK_KVK, base, CQ(2));
        tr_job(C, (const float*)(const GAS float*)in[8] + (size_t)j * KVL * 2048, (const float*)(const GAS float*)in[7] + (size_t)j * KVL, (bf16_t*)(ws + WS_WMIX + WM_KVV), 2048, KVL, 1024, MK_KVV, base, CQ(3));
        tr_job(C, (const float*)(const GAS float*)in[13] + (size_t)j * D * D, nullptr, (bf16_t*)(ws + WS_WMIX + WM_EOUT), D, D, D, MK_ID, base, CQ(4));
    } else {
        tr_job(C, (const float*)(const GAS float*)in[14] + (size_t)j * D * RIN, mixg, (bf16_t*)(ws + WS_WMIX + WM_RIN), RIN, D, RIN, MK_ID, base, CQ(5));
        tr_job(C, (const float*)(const GAS float*)in[17] + (size_t)j * RV * D, nullptr, (bf16_t*)(ws + WS_WMIX + WM_ROUT), D, RV, D, MK_ID, base, CQ(6));
    }
    }
    if (mask & PREP_FUP) tr_job(C, (const float*)(const GAS float*)in[19] + (size_t)L * D * FF2, (const float*)(const GAS float*)in[18] + (size_t)L * D, (bf16_t*)(ws + WS_WFFN + WF_UP), FF2, D, FF2, MK_FUP, base, CQ(7));
    if (mask & PREP_FDN) tr_job(C, (const float*)(const GAS float*)in[22] + (size_t)L * FF * D, nullptr, (bf16_t*)(ws + WS_WFFN + WF_DN), D, FF, D, MK_ID, base, CQ(8));
    if (mask & PREP_PLEG) tr_job(C, (const float*)(const GAS float*)in[24] + (size_t)L * D * D, (const float*)(const GAS float*)in[23] + (size_t)L * D, (bf16_t*)(ws + WS_WPLE + WP_G), D, D, D, MK_ID, base, CQ(9));
    if (mask & PREP_PLEU) tr_job(C, (const float*)(const GAS float*)in[25] + (size_t)L * PLE * D, nullptr, (bf16_t*)(ws + WS_WPLE + WP_U), D, PLE, D, MK_ID, base, CQ(10));
    if (mask & PREP_PLEU) cvt_rows(C, (const float*)(const GAS float*)in[1] + (size_t)L * T * PLE, (bf16_t*)(ws + WS_PBF), (size_t)T * PLE);
    if ((mask & PREP_MIX) && (L & 1) == 0) {
        const float* wsrc = (const float*)(const GAS float*)in[11] + (size_t)j * 8 * 128 * 128; bf16_t* wm = (bf16_t*)(ws + WS_WMIX + WM_WS);
        for (int i = C.bid * 512 + C.tid; i < 8 * 128 * 128; i += C.G * 512) { const int p = (i >> 7) & 127, q = i & 127; *(GAS bf16_t*)(wm + i) = (bf16_t)f2bf(((p >> 6) >= (q >> 6)) ? *(const GAS float*)(wsrc + i) : 0.f); }
    }
#undef CQ
    __syncthreads();
}

#define MFMA32(a, b, c) __builtin_amdgcn_mfma_f32_32x32x16_bf16((a), (b), (c), 0, 0, 0)
#define MFMA16(a, b, c) __builtin_amdgcn_mfma_f32_16x16x32_bf16((a), (b), (c), 0, 0, 0)
constexpr int AT_KST = 200, AT_VST = 72;
constexpr int AT_KB = 64 * AT_KST * 2, AT_VB = 128 * AT_VST * 2, AT_BUF = AT_KB + AT_VB;
__device__ __forceinline__ int swap23(int r) { return (r & ~12) | ((r & 4) << 1) | ((r & 8) >> 1); }
__device__ __forceinline__ bf16x8 pack_frag(const f32x16& x, int s) {
    u32x4 p; p.x = pk2(x[8 * s + 0], x[8 * s + 1]); p.y = pk2(x[8 * s + 2], x[8 * s + 3]); p.z = pk2(x[8 * s + 4], x[8 * s + 5]); p.w = pk2(x[8 * s + 6], x[8 * s + 7]);
    return __builtin_bit_cast(bf16x8, p);
}

__device__ __forceinline__ void attn_qk(const LAS bf16_t* ks, int r, int hh, const bf16x8 (&qf)[12], f32x16 (&st)[2]) {
#pragma unroll
    for (int kb = 0; kb < 2; ++kb) {
#pragma unroll
        for (int j = 0; j < 16; ++j) st[kb][j] = 0.f;
        const LAS bf16_t* kp = ks + (32 * kb + r) * AT_KST + 8 * hh;
        bf16x8 a0 = *(const LAS bf16x8*)(kp), a1 = *(const LAS bf16x8*)(kp + 16);
#pragma unroll
        for (int s = 0; s < 12; s += 2) {
            st[kb] = MFMA32(a0, qf[s], st[kb]); if (s + 2 < 12) a0 = *(const LAS bf16x8*)(kp + 16 * (s + 2));
            st[kb] = MFMA32(a1, qf[s + 1], st[kb]); if (s + 3 < 12) a1 = *(const LAS bf16x8*)(kp + 16 * (s + 3));
        }
    }
}
__device__ __forceinline__ void attn_sm(f32x16 (&st)[2], float& mrow, float& lrow, f32x16 (&o)[4], bf16x8 (&pf)[2][2]) {
    float mx = st[0][0];
#pragma unroll
    for (int j = 1; j < 16; ++j) mx = fmaxf(mx, st[0][j]);
#pragma unroll
    for (int j = 0; j < 16; ++j) mx = fmaxf(mx, st[1][j]);
    mx = fmaxf(mx, __shfl_xor(mx, 32));
    const float mn = fmaxf(mrow, mx), alpha = fexp2(mrow - mn);
    float rsum = 0.f;
#pragma unroll
    for (int kb = 0; kb < 2; ++kb)
#pragma unroll
        for (int j = 0; j < 16; ++j) { const float p = fexp2(st[kb][j] - mn); st[kb][j] = p; rsum += p; }
    rsum += __shfl_xor(rsum, 32);
    lrow = lrow * alpha + rsum; mrow = mn;
#pragma unroll
    for (int db = 0; db < 4; ++db) o[db] *= alpha;
#pragma unroll
    for (int kb = 0; kb < 2; ++kb)
#pragma unroll
        for (int s = 0; s < 2; ++s) pf[kb][s] = pack_frag(st[kb], s);
}
__device__ __forceinline__ void attn_pv(const LAS bf16_t* vs, int r, int hh, const bf16x8 (&pf)[2][2], f32x16 (&o)[4]) {
    const LAS bf16_t* vp = vs + r * AT_VST + 8 * hh;
    bf16x8 v0 = *(const LAS bf16x8*)(vp), v1 = *(const LAS bf16x8*)(vp + 16), v2 = *(const LAS bf16x8*)(vp + 32), v3 = *(const LAS bf16x8*)(vp + 48);
#pragma unroll
    for (int db = 0; db < 4; ++db) {
        o[db] = MFMA32(v0, pf[0][0], o[db]); if (db < 3) v0 = *(const LAS bf16x8*)(vp + 32 * (db + 1) * AT_VST);
        o[db] = MFMA32(v1, pf[0][1], o[db]); if (db < 3) v1 = *(const LAS bf16x8*)(vp + 32 * (db + 1) * AT_VST + 16);
        o[db] = MFMA32(v2, pf[1][0], o[db]); if (db < 3) v2 = *(const LAS bf16x8*)(vp + 32 * (db + 1) * AT_VST + 32);
        o[db] = MFMA32(v3, pf[1][1], o[db]); if (db < 3) v3 = *(const LAS bf16x8*)(vp + 32 * (db + 1) * AT_VST + 48);
    }
}
__device__ __forceinline__ void attn_unit(const Ctx& C, const bf16_t* Q, const bf16_t* Kn, const bf16_t* Kr, const bf16_t* Vt, bf16_t* ab, int b, int h, int qt) {
    const int lane = C.lane, w8 = C.wave, r = lane & 31, hh = lane >> 5, tid = C.tid;
    const bool late = w8 >= 4;
    const int tq = b * SEQ + qt * 256 + w8 * 32 + r;
    bf16x8 qf[12];
    { const bf16_t* qp = Q + ((size_t)tq * 8 + h) * QKD + 8 * hh;
#pragma unroll
      for (int ks = 0; ks < 12; ++ks) qf[ks] = *(const GAS bf16x8*)(qp + 16 * ks); }
    const int cwv = qt * 4 + (w8 >> 1), nt = qt * 4 + 4;
    f32x16 o[4];
#pragma unroll
    for (int i = 0; i < 4; ++i)
#pragma unroll
        for (int j = 0; j < 16; ++j) o[i][j] = 0.f;
    float mrow = -1e30f, lrow = 0.f;
    const int srow = tid >> 3, c8 = tid & 7;
    const size_t tk0 = (size_t)b * SEQ + swap23(srow);
    const bf16_t* kn0 = Kn + (tk0 * 8 + h) * 128 + c8 * 8; const bf16_t* kr0 = Kr + tk0 * 64 + c8 * 8;
    const bf16_t* vt0 = Vt + (size_t)(h * 128 + srow) * VTP + (size_t)b * SEQ + c8 * 8;
    const int kd0 = (srow * AT_KST + c8 * 8) * 2, vd0 = AT_KB + (srow * AT_VST + c8 * 8) * 2;
#define AT_LOAD(kt_) do { kreg[0] = *(const GAS u32x4*)(kn0 + (size_t)(kt_) * (64 * 1024)); kreg[1] = *(const GAS u32x4*)(kn0 + (size_t)(kt_) * (64 * 1024) + 64); kreg[2] = *(const GAS u32x4*)(kr0 + (size_t)(kt_) * (64 * 64)); \
        vreg[0] = *(const GAS u32x4*)(vt0 + (kt_) * 64); vreg[1] = *(const GAS u32x4*)(vt0 + (size_t)64 * VTP + (kt_) * 64); } while (0)
#define AT_WRITE(base_) do { LAS unsigned char* nb_ = (base_); *(LAS u32x4*)(nb_ + kd0) = kreg[0]; *(LAS u32x4*)(nb_ + kd0 + 128) = kreg[1]; *(LAS u32x4*)(nb_ + kd0 + 256) = kreg[2]; \
        *(LAS u32x4*)(nb_ + vd0) = vreg[0]; *(LAS u32x4*)(nb_ + vd0 + 64 * AT_VST * 2) = vreg[1]; } while (0)
    u32x4 kreg[3], vreg[2];
    AT_LOAD(0); AT_WRITE(C.lds);
    __syncthreads();
    if (late && nt > 1) AT_LOAD(1);
    int bc = 0;
    for (int kt = 0; kt < nt; ++kt) {
        const bool more = kt + 1 < nt;
        const int bn = bc == 2 ? 0 : bc + 1;
        if (!late && more) AT_LOAD(kt + 1);
        f32x16 st[2]; bf16x8 pf[2][2];
        const bool act = kt <= cwv;
        if (act) attn_qk((const LAS bf16_t*)(C.lds + bc * AT_BUF), r, hh, qf, st);
        if (late) {
            if (more) AT_WRITE(C.lds + bn * AT_BUF);
            if (kt + 2 < nt) AT_LOAD(kt + 2);
            __syncthreads();
        }
        if (act) {
            attn_sm(st, mrow, lrow, o, pf);
            attn_pv((const LAS bf16_t*)(C.lds + bc * AT_BUF + AT_KB), r, hh, pf, o);
        }
        if (!late) {
            if (more) AT_WRITE(C.lds + bn * AT_BUF);
            __syncthreads();
        }
        bc = bn;
    }
    const float inv = 1.0f / lrow;
    const int l2_ = lane_id_now();
    bf16_t* op = ab + (size_t)(b * SEQ + qt * 256 + w8 * 32 + (l2_ & 31)) * D + h * 128 + 4 * (l2_ >> 5);
#pragma unroll
    for (int db = 0; db < 4; ++db)
#pragma unroll
        for (int g = 0; g < 4; ++g) { u32x2 w; w.x = pk2(o[db][4 * g] * inv, o[db][4 * g + 1] * inv); w.y = pk2(o[db][4 * g + 2] * inv, o[db][4 * g + 3] * inv); *(GAS u32x2*)(op + 32 * db + 8 * g) = w; }
    __syncthreads();
#undef AT_LOAD
#undef AT_WRITE
}
__device__ __forceinline__ void phase_attn(const Ctx& C0, unsigned char* ws) {
    const Ctx C = fresh(C0);
    const bf16_t* Q = (const bf16_t*)ACT_TM(ws, C, A_Q, QUPN); const bf16_t* Kn = (const bf16_t*)ACT_TM(ws, C, A_KN, 1024); const bf16_t* Kr = (const bf16_t*)ACT_TM(ws, C, A_KROT, 64);
    const bf16_t* Vt = (const bf16_t*)ACT_VT(ws, C); bf16_t* ab = (bf16_t*)ACT_TM(ws, C, A_AB, D);
    for (int li = rank_of(C); li < 32; li += nper_of(C)) {
        const int slot = grp_of(C) * 32 + li;
        const int bh = slot >> 1, b = bh >> 3, h = bh & 7, odd = slot & 1;
#pragma unroll 1
        for (int i = 0; i < 4; ++i) {
            const int big = odd ? ((i & 2) ? 5 : 6) : ((i & 2) ? 4 : 7), qt = (i & 1) ? 7 - big : big;
            attn_unit(C, Q, Kn, Kr, Vt, ab, b, h, qt);
        }
    }
}

constexpr int SG_XST = 136;
constexpr int SG_STAT = 0, SG_XT = 1024, SG_SL = SG_XT + 128 * SG_XST * 2, SG_SST = 132;
__device__ __forceinline__ void sgu_unit(const Ctx& C, const bf16_t* ug, const bf16_t* vg, const float* psv, const bf16_t* wm, const float* lng, const float* lnb, const float* bs, bf16_t* ab, int blk, int g) {
    const int tid = C.tid, lane = C.lane, w8 = C.wave, r = lane & 31, hh = lane >> 5, t0 = blk * 128;
    LAS float* stat = (LAS float*)(C.lds + SG_STAT); LAS bf16_t* xt = (LAS bf16_t*)(C.lds + SG_XT); LAS float* sl = (LAS float*)(C.lds + SG_SL);
    if (tid < 128) {
        const GAS f32x4* p = (const GAS f32x4*)(psv + (size_t)(t0 + tid) * 32); float s1 = 0.f, s2 = 0.f;
#pragma unroll
        for (int i = 0; i < 8; ++i) { const f32x4 v = p[i]; s1 += v[0] + v[2]; s2 += v[1] + v[3]; }
        const float mu = s1 * (1.0f / 1024.0f), var = s2 * (1.0f / 1024.0f) - mu * mu;
        stat[tid * 2] = mu; stat[tid * 2 + 1] = rsqrtf(fmaxf(var, 0.f) + EPS);
    }
    __syncthreads();
    {
        const int tg = tid >> 4, cg = tid & 15, c0 = g * 128 + 8 * cg;
        const f32x4 ga = *(const GAS f32x4*)(lng + c0), gb = *(const GAS f32x4*)(lng + c0 + 4), ba = *(const GAS f32x4*)(lnb + c0), bb = *(const GAS f32x4*)(lnb + c0 + 4);
        float xn[4][8];
#pragma unroll
        for (int i = 0; i < 4; ++i) {
            const u32x4 w = *(const GAS u32x4*)(vg + (size_t)(t0 + 4 * tg + i) * 1024 + c0); const float mu = stat[(4 * tg + i) * 2], rsd = stat[(4 * tg + i) * 2 + 1];
            xn[i][0] = (bf_lo(w.x) - mu) * rsd * ga[0] + ba[0]; xn[i][1] = (bf_hi(w.x) - mu) * rsd * ga[1] + ba[1]; xn[i][2] = (bf_lo(w.y) - mu) * rsd * ga[2] + ba[2]; xn[i][3] = (bf_hi(w.y) - mu) * rsd * ga[3] + ba[3];
            xn[i][4] = (bf_lo(w.z) - mu) * rsd * gb[0] + bb[0]; xn[i][5] = (bf_hi(w.z) - mu) * rsd * gb[1] + bb[1]; xn[i][6] = (bf_lo(w.w) - mu) * rsd * gb[2] + bb[2]; xn[i][7] = (bf_hi(w.w) - mu) * rsd * gb[3] + bb[3];
        }
#pragma unroll
        for (int j = 0; j < 8; ++j) { u32x2 w; w.x = pk2(xn[0][j], xn[1][j]); w.y = pk2(xn[2][j], xn[3][j]); *(LAS u32x2*)(xt + (8 * cg + j) * SG_XST + 4 * tg) = w; }
    }
    __syncthreads();
    {
        const int pb = w8 >> 1, cb0 = 2 * (w8 & 1);
        f32x16 acc[2];
#pragma unroll
        for (int i = 0; i < 2; ++i)
#pragma unroll
            for (int j = 0; j < 16; ++j) acc[i][j] = 0.f;
        const bf16_t* wp = wm + ((size_t)g * 128 + 32 * pb + r) * 128 + 8 * hh;
#pragma unroll
        for (int s = 0; s < 8; ++s) {
            const bf16x8 a = *(const GAS bf16x8*)(wp + 16 * s);
#pragma unroll
            for (int i = 0; i < 2; ++i) { const bf16x8 bq = *(const LAS bf16x8*)(xt + (32 * (cb0 + i) + r) * SG_XST + 16 * s + 8 * hh); acc[i] = MFMA32(a, bq, acc[i]); }
        }
#pragma unroll
        for (int i = 0; i < 2; ++i)
#pragma unroll
            for (int j = 0; j < 16; ++j) { const int p = 32 * pb + (j & 3) + 8 * (j >> 2) + 4 * hh; sl[p * SG_SST + 32 * (cb0 + i) + r] = acc[i][j] + *(const GAS float*)(bs + g * 128 + p); }
    }
    __syncthreads();
#pragma unroll
    for (int i = 0; i < 4; ++i) {
        const int p = (tid >> 4) + 32 * i, cg = tid & 15; const size_t tok = (size_t)(t0 + p);
        const f32x4 sa = *(const LAS f32x4*)(sl + p * SG_SST + 8 * cg), sb = *(const LAS f32x4*)(sl + p * SG_SST + 8 * cg + 4);
        const u32x4 w = *(const GAS u32x4*)(ug + tok * 1024 + g * 128 + 8 * cg);
        f32x4 oa, ob; oa[0] = gelu_t(bf_lo(w.x)) * sa[0]; oa[1] = gelu_t(bf_hi(w.x)) * sa[1]; oa[2] = gelu_t(bf_lo(w.y)) * sa[2]; oa[3] = gelu_t(bf_hi(w.y)) * sa[3];
        ob[0] = gelu_t(bf_lo(w.z)) * sb[0]; ob[1] = gelu_t(bf_hi(w.z)) * sb[1]; ob[2] = gelu_t(bf_lo(w.w)) * sb[2]; ob[3] = gelu_t(bf_hi(w.w)) * sb[3];
        *(GAS u32x4*)(ab + tok * D + 1024 + g * 128 + 8 * cg) = pack8(oa, ob);
    }
    __syncthreads();
}
__device__ __forceinline__ void phase_sgu(const Ctx& C0, unsigned char* ws, const float* lng, const float* lnb, const float* bs) {
    const Ctx C = fresh(C0);
    const bf16_t* ug = (const bf16_t*)ACT_TM(ws, C, A_UG, 1024); const bf16_t* vg = (const bf16_t*)ACT_TM(ws, C, A_VG, 1024); const float* psv = (const float*)(ws + WS_PSV);
    const bf16_t* wm = (const bf16_t*)(ws + WS_WMIX + WM_WS); bf16_t* ab = (bf16_t*)ACT_TM(ws, C, A_AB, D);
#pragma unroll 1
    for (int li = rank_of(C); li < 256; li += nper_of(C)) { const int it = grp_of(C) * 256 + li; sgu_unit(C, ug, vg, psv, wm, lng, lnb, bs, ab, it >> 3, it & 7); }
}

constexpr int RT_QST = 264, RT_TST = 72;
constexpr int RT_QS = 0, RT_KS = 64 * RT_QST * 2, RT_KT = 2 * RT_KS, RT_VT = RT_KT + 256 * RT_TST * 2, RT_PS = RT_VT + 128 * RT_TST * 2, RT_END = RT_PS + 64 * RT_TST * 2;
static_assert(RT_END <= LDS_MISC, "retention LDS");
__device__ __forceinline__ void ret_unit(const Ctx& C, const bf16_t* rq, const bf16_t* rk, bf16_t* rv, int b, int h, int dvq, bool do_store) {
    const int tid = C.tid, lane = C.lane, w8 = C.wave, lr = lane & 15, lg = lane >> 4;
    LAS bf16_t* Qs = (LAS bf16_t*)(C.lds + RT_QS); LAS bf16_t* Ks = (LAS bf16_t*)(C.lds + RT_KS); LAS bf16_t* KT = (LAS bf16_t*)(C.lds + RT_KT);
    LAS bf16_t* VT = (LAS bf16_t*)(C.lds + RT_VT); LAS bf16_t* Ps = (LAS bf16_t*)(C.lds + RT_PS);
    const float lg2 = h == 0 ? -4.5803689613e-02f : h == 1 ? -2.2720076500e-02f : h == 2 ? -1.1315313228e-02f : h == 3 ? -5.6465631411e-03f : h == 4 ? -2.8205190624e-03f : h == 5 ? -1.4095702547e-03f : h == 6 ? -7.0461297659e-04f : -3.5226347163e-04f;
    const float g64 = h == 0 ? 1.3108403248e-01f : h == 1 ? 3.6498652424e-01f : h == 2 ? 6.0534099144e-01f : h == 3 ? 7.7841960936e-01f : h == 4 ? 8.8238904203e-01f : h == 5 ? 9.3938437596e-01f : h == 6 ? 9.6922583743e-01f : 9.8449455892e-01f;
    f32x4 st[16];
#pragma unroll
    for (int i = 0; i < 16; ++i) st[i] = (f32x4){0.f, 0.f, 0.f, 0.f};
    const int tg1 = tid >> 5, cg1 = tid & 31;
    const int tg2 = tid & 15, cg2 = tid >> 4;
    float kd[4];
#pragma unroll
    for (int i = 0; i < 4; ++i) kd[i] = fexp2(lg2 * (float)(63 - (4 * tg2 + i)));
    const size_t tb = (size_t)b * SEQ;
    const bf16_t* qsrc = rq + (tb + 4 * tg1) * 2048 + h * 256 + 8 * cg1;
    const bf16_t* ksrc = rk + (tb + 4 * tg1) * 2048 + h * 256 + 8 * cg1;
    bf16_t* vbase = rv + tb * RV + h * 512 + dvq * 128;
    const bf16_t* vsrc = vbase + (size_t)(4 * tg2) * RV + 4 * cg2;
    const int qdst = (4 * tg1) * RT_QST + 32 * (cg1 >> 2) + 16 * (cg1 & 1) + 4 * ((cg1 >> 1) & 1);
    const int kpat = (4 * tg2) * RT_QST + 32 * (cg2 >> 2) + 16 * (cg2 & 1) + 4 * ((cg2 >> 1) & 1);
    u32x4 qr[4], kr[4]; u32x2 vr[4];
#define RT_LOAD(n) do { _Pragma("unroll") for (int i = 0; i < 4; ++i) { qr[i] = *(const GAS u32x4*)(qsrc + ((size_t)(n) * 64 + i) * 2048); kr[i] = *(const GAS u32x4*)(ksrc + ((size_t)(n) * 64 + i) * 2048); \
        vr[i] = *(const GAS u32x2*)(vsrc + ((size_t)(n) * 64 + i) * RV); } } while (0)
#define RT_STAGE() do { \
        _Pragma("unroll") for (int i = 0; i < 4; ++i) { \
            *(LAS u32x2*)(Qs + qdst + i * RT_QST) = (u32x2){qr[i].x, qr[i].y}; *(LAS u32x2*)(Qs + qdst + i * RT_QST + 8) = (u32x2){qr[i].z, qr[i].w}; \
            *(LAS u32x2*)(Ks + qdst + i * RT_QST) = (u32x2){kr[i].x, kr[i].y}; *(LAS u32x2*)(Ks + qdst + i * RT_QST + 8) = (u32x2){kr[i].z, kr[i].w}; } \
        _Pragma("unroll") for (int w = 0; w < 2; ++w) { \
            u32x2 lo, hi; lo.x = (vr[0][w] & 0xffffu) | (vr[1][w] << 16); lo.y = (vr[2][w] & 0xffffu) | (vr[3][w] << 16); \
            hi.x = (vr[0][w] >> 16) | (vr[1][w] & 0xffff0000u); hi.y = (vr[2][w] >> 16) | (vr[3][w] & 0xffff0000u); \
            *(LAS u32x2*)(VT + (4 * cg2 + 2 * w) * RT_TST + 4 * tg2) = lo; *(LAS u32x2*)(VT + (4 * cg2 + 2 * w + 1) * RT_TST + 4 * tg2) = hi; } \
    } while (0)
    RT_LOAD(0);
    RT_STAGE();
    __syncthreads();
#pragma unroll 1
    for (int n = 0; n < 32; ++n) {
        const bool more = n + 1 < 32;
        if (more) RT_LOAD(n + 1);
        {
            u32x2 pl[4], ph[4];
#pragma unroll
            for (int i = 0; i < 4; ++i) { pl[i] = *(const LAS u32x2*)(Ks + kpat + i * RT_QST); ph[i] = *(const LAS u32x2*)(Ks + kpat + i * RT_QST + 8); }
#pragma unroll
            for (int w = 0; w < 4; ++w) {
                const unsigned x0 = (w < 2) ? pl[0][w & 1] : ph[0][w & 1], x1 = (w < 2) ? pl[1][w & 1] : ph[1][w & 1], x2 = (w < 2) ? pl[2][w & 1] : ph[2][w & 1], x3 = (w < 2) ? pl[3][w & 1] : ph[3][w & 1];
                *(LAS u32x2*)(KT + (8 * cg2 + 2 * w) * RT_TST + 4 * tg2) = (u32x2){pk2(bf_lo(x0) * kd[0], bf_lo(x1) * kd[1]), pk2(bf_lo(x2) * kd[2], bf_lo(x3) * kd[3])};
                *(LAS u32x2*)(KT + (8 * cg2 + 2 * w + 1) * RT_TST + 4 * tg2) = (u32x2){pk2(bf_hi(x0) * kd[0], bf_hi(x1) * kd[1]), pk2(bf_hi(x2) * kd[2], bf_hi(x3) * kd[3])};
            }
            const int qi = w8 >> 1, ki0 = 2 * (w8 & 1);
            f32x4 pa[2] = {(f32x4){0.f, 0.f, 0.f, 0.f}, (f32x4){0.f, 0.f, 0.f, 0.f}};
            {
                const LAS bf16_t* qp = Qs + (16 * qi + lr) * RT_QST + 8 * lg; const LAS bf16_t* kp0 = Ks + (16 * ki0 + lr) * RT_QST + 8 * lg; const LAS bf16_t* kp1 = kp0 + 16 * RT_QST;
                bf16x8 fa[2], fb0[2], fb1[2];
#pragma unroll
                for (int s = 0; s < 2; ++s) { fa[s] = *(const LAS bf16x8*)(qp + 32 * s); fb0[s] = *(const LAS bf16x8*)(kp0 + 32 * s); fb1[s] = *(const LAS bf16x8*)(kp1 + 32 * s); }
#pragma unroll
                for (int s = 0; s < 8; ++s) {
                    pa[0] = MFMA16(fb0[s & 1], fa[s & 1], pa[0]); pa[1] = MFMA16(fb1[s & 1], fa[s & 1], pa[1]);
                    if (s + 2 < 8) { fa[s & 1] = *(const LAS bf16x8*)(qp + 32 * (s + 2)); fb0[s & 1] = *(const LAS bf16x8*)(kp0 + 32 * (s + 2)); fb1[s & 1] = *(const LAS bf16x8*)(kp1 + 32 * (s + 2)); }
                }
            }
#pragma unroll
            for (int j = 0; j < 2; ++j) { float pv[4];
#pragma unroll
                for (int e = 0; e < 4; ++e) { const int iq = 16 * qi + lr, jk = 16 * (ki0 + j) + 4 * lg + e; const int dd = iq > jk ? iq - jk : jk - iq; pv[e] = pa[j][e] * fexp2(lg2 * (float)dd); }
                *(LAS u32x2*)(Ps + (16 * qi + lr) * RT_TST + 16 * (ki0 + j) + 4 * lg) = (u32x2){pk2(pv[0], pv[1]), pk2(pv[2], pv[3])}; }
        }
        __syncthreads();
        f32x4 ot[4];
#pragma unroll
        for (int i = 0; i < 4; ++i) ot[i] = (f32x4){0.f, 0.f, 0.f, 0.f};
        {
            const LAS bf16_t* qp = Qs + lr * RT_QST + 8 * lg;
            bf16x8 bq[2][4];
#pragma unroll
            for (int tt = 0; tt < 4; ++tt) bq[0][tt] = *(const LAS bf16x8*)(qp + 16 * tt * RT_QST);
#pragma unroll
            for (int c = 0; c < 8; ++c) {
                if (c + 1 < 8) {
#pragma unroll
                    for (int tt = 0; tt < 4; ++tt) bq[(c + 1) & 1][tt] = *(const LAS bf16x8*)(qp + 16 * tt * RT_QST + 32 * (c + 1));
                }
                u32x4 sp; sp.x = pk2(st[2 * c][0], st[2 * c][1]); sp.y = pk2(st[2 * c][2], st[2 * c][3]); sp.z = pk2(st[2 * c + 1][0], st[2 * c + 1][1]); sp.w = pk2(st[2 * c + 1][2], st[2 * c + 1][3]);
                const bf16x8 sf = __builtin_bit_cast(bf16x8, sp);
#pragma unroll
                for (int tt = 0; tt < 4; ++tt) ot[tt] = MFMA16(sf, bq[c & 1][tt], ot[tt]);
            }
        }
#pragma unroll
        for (int tt = 0; tt < 4; ++tt) ot[tt] *= fexp2(lg2 * (float)(16 * tt + lr + 1));
        bf16x8 vt[2];
#pragma unroll
        for (int s = 0; s < 2; ++s) vt[s] = *(const LAS bf16x8*)(VT + (16 * w8 + lr) * RT_TST + 32 * s + 8 * lg);
        {
            bf16x8 bp[2][4];
#pragma unroll
            for (int s = 0; s < 2; ++s)
#pragma unroll
                for (int tt = 0; tt < 4; ++tt) bp[s][tt] = *(const LAS bf16x8*)(Ps + (16 * tt + lr) * RT_TST + 32 * s + 8 * lg);
#pragma unroll
            for (int s = 0; s < 2; ++s)
#pragma unroll
                for (int tt = 0; tt < 4; ++tt) ot[tt] = MFMA16(vt[s], bp[s][tt], ot[tt]);
        }
#pragma unroll
        for (int tt = 0; tt < 4; ++tt) if (do_store) *(GAS u32x2*)(vbase + (size_t)(n * 64 + 16 * tt + lr) * RV + 16 * w8 + 4 * lg) = (u32x2){pk2(ot[tt][0], ot[tt][1]), pk2(ot[tt][2], ot[tt][3])};
        {
            const LAS bf16_t* tp = KT + lr * RT_TST + 8 * lg;
            bf16x8 ka[3][2];
#pragma unroll
            for (int k = 0; k < 2; ++k)
#pragma unroll
                for (int s = 0; s < 2; ++s) ka[k][s] = *(const LAS bf16x8*)(tp + 16 * k * RT_TST + 32 * s);
#pragma unroll
            for (int kb = 0; kb < 16; ++kb) {
                if (kb + 2 < 16) {
#pragma unroll
                    for (int s = 0; s < 2; ++s) ka[(kb + 2) % 3][s] = *(const LAS bf16x8*)(tp + 16 * (kb + 2) * RT_TST + 32 * s);
                }
                st[kb] *= g64;
                st[kb] = MFMA16(ka[kb % 3][0], vt[0], st[kb]); st[kb] = MFMA16(ka[kb % 3][1], vt[1], st[kb]);
            }
        }
        __syncthreads();
        if (more) RT_STAGE();
        __syncthreads();
    }
#undef RT_LOAD
#undef RT_STAGE
}
__device__ __forceinline__ void phase_ret(const Ctx& C0, unsigned char* ws, bool do_store) {
    const Ctx C = fresh(C0);
    const bf16_t* rq = (const bf16_t*)ACT_TM(ws, C, A_RQ, 2048); const bf16_t* rk = (const bf16_t*)ACT_TM(ws, C, A_RK, 2048); bf16_t* rv = (bf16_t*)ACT_TM(ws, C, A_RVV, RV);
#pragma unroll 1
    for (int li = rank_of(C); li < 64; li += nper_of(C)) { const int it = grp_of(C) * 64 + li; ret_unit(C, rq, rk, rv, it >> 5, (it >> 2) & 7, it & 3, do_store); }
}
__device__ __forceinline__ void phase_retnorm(const Ctx& C0, unsigned char* ws, const float* gng, const float* gnb, bool do_store = true) {
    const Ctx C = fresh(C0);
    bf16_t* rr = (bf16_t*)ACT_TM(ws, C, A_RVV, RV); const bf16_t* sg = (const bf16_t*)ACT_TM(ws, C, A_RSG, RV);
    const int gw = rank_of(C) * 8 + C.wave, NGW = nper_of(C) * 8, rbase = grp_of(C) * (4096 * 8);
    for (int lr0 = gw * 4; lr0 < 4096 * 8; lr0 += NGW * 4) { const int row0 = rbase + lr0;
        u32x4 w[4], gq[4];
#pragma unroll
        for (int k = 0; k < 4; ++k) { const size_t off = (size_t)(row0 + k) * 512 + 8 * C.lane; w[k] = __builtin_nontemporal_load((const GAS u32x4*)(rr + off)); gq[k] = __builtin_nontemporal_load((const GAS u32x4*)(sg + off)); }
#pragma unroll
        for (int k = 0; k < 4; ++k) {
            const int row = row0 + k, hd = row & 7; const size_t off = (size_t)row * 512 + 8 * C.lane;
            float x[8] = {bf_lo(w[k].x), bf_hi(w[k].x), bf_lo(w[k].y), bf_hi(w[k].y), bf_lo(w[k].z), bf_hi(w[k].z), bf_lo(w[k].w), bf_hi(w[k].w)};
            float s = 0.f;
#pragma unroll
            for (int i = 0; i < 8; ++i) s += x[i];
            const float mu = wave_sum(s) * (1.0f / 512.0f); float q = 0.f;
#pragma unroll
            for (int i = 0; i < 8; ++i) { x[i] -= mu; q += x[i] * x[i]; }
            const float rsd = rsqrtf(wave_sum(q) * (1.0f / 512.0f) + EPS);
            const int c0 = hd * 512 + 8 * C.lane;
            const f32x4 ga = *(const GAS f32x4*)(gng + c0), gb = *(const GAS f32x4*)(gng + c0 + 4), ba = *(const GAS f32x4*)(gnb + c0), bb = *(const GAS f32x4*)(gnb + c0 + 4);
            f32x4 oa, ob;
            float gg[8] = {bf_lo(gq[k].x), bf_hi(gq[k].x), bf_lo(gq[k].y), bf_hi(gq[k].y), bf_lo(gq[k].z), bf_hi(gq[k].z), bf_lo(gq[k].w), bf_hi(gq[k].w)};
#pragma unroll
            for (int i = 0; i < 8; ++i) gg[i] *= sigmoid_f(gg[i]);
            oa[0] = (x[0] * rsd * ga[0] + ba[0]) * gg[0]; oa[1] = (x[1] * rsd * ga[1] + ba[1]) * gg[1]; oa[2] = (x[2] * rsd * ga[2] + ba[2]) * gg[2]; oa[3] = (x[3] * rsd * ga[3] + ba[3]) * gg[3];
            ob[0] = (x[4] * rsd * gb[0] + bb[0]) * gg[4]; ob[1] = (x[5] * rsd * gb[1] + bb[1]) * gg[5]; ob[2] = (x[6] * rsd * gb[2] + bb[2]) * gg[6]; ob[3] = (x[7] * rsd * gb[3] + bb[3]) * gg[7];
            const u32x4 res_ = pack8(oa, ob); asm volatile("" :: "v"(res_)); if (do_store) *(GAS u32x4*)(rr + off) = res_;
        }
    }
}
__device__ __forceinline__ void phase_fixup(const Ctx& C0, unsigned char* ws, const float* cw3, const float* cb) {
    const Ctx C = fresh(C0);
    const float* side = (const float*)(ws + WS_SIDE); bf16_t* mo = (bf16_t*)ACT_TM(ws, C, A_M, FF);
    for (int li = rank_of(C) * 512 + C.tid; li < 16 * (FF / 4); li += nper_of(C) * 512) { const int i = grp_of(C) * (16 * (FF / 4)) + li;
        const int pm = i / (FF / 4), c = (i % (FF / 4)) * 4; const bool first = (pm & 7) == 0;
        f32x4 cv[2][2];
#pragma unroll
        for (int hv = 0; hv < 2; ++hv) {
            const int ch = hv * FF + c;
            const f32x4 z = {0.f, 0.f, 0.f, 0.f};
            const f32x4 am2 = first ? z : *(const GAS f32x4*)(side + ((size_t)(pm - 1) * 4 + 2) * FF2 + ch), am1 = first ? z : *(const GAS f32x4*)(side + ((size_t)(pm - 1) * 4 + 3) * FF2 + ch);
            const f32x4 a0 = *(const GAS f32x4*)(side + ((size_t)pm * 4 + 0) * FF2 + ch), a1 = *(const GAS f32x4*)(side + ((size_t)pm * 4 + 1) * FF2 + ch);
            const f32x4 w0 = *(const GAS f32x4*)(cw3 + ch), w1 = *(const GAS f32x4*)(cw3 + FF2 + ch), w2 = *(const GAS f32x4*)(cw3 + 2 * FF2 + ch), bb = *(const GAS f32x4*)(cb + ch);
            cv[hv][0] = bb + w0 * am2 + w1 * am1 + w2 * a0; cv[hv][1] = bb + w0 * am1 + w1 * a0 + w2 * a1;
        }
#pragma unroll
        for (int rw = 0; rw < 2; ++rw) { f32x4 g = cv[0][rw];
#pragma unroll
            for (int k = 0; k < 4; ++k) g[k] = gelu_t(g[k]) * cv[1][rw][k];
            *(GAS u32x2*)(mo + (size_t)(pm * 256 + rw) * FF + c) = (u32x2){pk2(g[0], g[1]), pk2(g[2], g[3])}; }
    }
}
__device__ __forceinline__ void phase_final(const Ctx& C0, float* out, const bf16_t* hb, const float* psh, const float* g) {
    const Ctx C = fresh(C0);
    const int gw = rank_of(C) * 8 + C.wave, NGW = nper_of(C) * 8;
    for (int lr = gw; lr < 4096; lr += NGW) { const int row = grp_of(C) * 4096 + lr;
        float s = C.lane < 8 ? *(const GAS float*)(psh + (size_t)row * 8 + C.lane) : 0.f; s = wave_sum(s);
        const float rsd = rsqrtf(s * (1.0f / D) + EPS); float* o = out + (size_t)row * D; const bf16_t* hr = hb + (size_t)row * D;
#pragma unroll
        for (int j = 0; j < 4; ++j) { const int c = j * 512 + 8 * C.lane; const u32x4 w = *(const GAS u32x4*)(hr + c); const f32x4 ga = *(const GAS f32x4*)(g + c), gb = *(const GAS f32x4*)(g + c + 4);
            f32x4 oa, ob; oa[0] = bf_lo(w.x); oa[1] = bf_hi(w.x); oa[2] = bf_lo(w.y); oa[3] = bf_hi(w.y); ob[0] = bf_lo(w.z); ob[1] = bf_hi(w.z); ob[2] = bf_lo(w.w); ob[3] = bf_hi(w.w);
            *(GAS f32x4*)(o + c) = oa * rsd * ga; *(GAS f32x4*)(o + c + 4) = ob * rsd * gb; }
    }
}

constexpr int NPHASE = 38;
struct Params { const void* in[27]; float* out; unsigned char* ws; int ph_lo, ph_hi; };
#define GEMM_PHASE(EPI, Aptr, Bptr, Mv, Nv, Kv, ...) do { pg8::Gemm g_{(const bf16_t*)(Aptr), (const bf16_t*)(Bptr), (Mv), (Nv), (Kv)}; pg8::StaticOrder S_; S_.init((Mv), (Nv), C.G, C.bid); \
        pg8::EPI E_{__VA_ARGS__}; pg8::gemm_phase<pg8::EPI, pg8::StaticOrder, true, true>((PG8_LAS unsigned char*)C.lds, g_, S_, E_, C.wave); } while (0)

template <class Tp> __device__ __forceinline__ Tp* opq(Tp* p) { asm volatile("" : "+s"(p)); return (Tp*)(GAS Tp*)p; }
#define SITE_VARS unsigned char* ws = opq(ws0); float* out = (float*)opq((unsigned char*)out0); unsigned char* act = ws + WS_ACT; (void)act; (void)out; \
    float* tabm = (float*)(ws + WS_TABM); float* tabr = (float*)(ws + WS_TABR); float* psq = (float*)(ws + WS_PSQ); float* pskv = (float*)(ws + WS_PSKV); float* psv = (float*)(ws + WS_PSV); (void)tabm; (void)tabr; (void)psq; (void)pskv; (void)psv; \
    bf16_t* hbc = (bf16_t*)(ws + (cur ? WS_HB1 : WS_HB0)); bf16_t* hbn = (bf16_t*)(ws + (cur ? WS_HB0 : WS_HB1)); float* psc = (float*)(ws + (cur ? WS_PSH1 : WS_PSH0)); float* psn = (float*)(ws + (cur ? WS_PSH0 : WS_PSH1)); (void)hbc; (void)hbn; (void)psc; (void)psn;
__global__ void __launch_bounds__(512, 2) fwd(Params P) {
    extern __shared__ __attribute__((aligned(16))) unsigned char lds_raw[];
    Ctx C; C.lds = (LAS unsigned char*)lds_raw; C.tid = threadIdx.x; C.lane = C.tid & 63; C.wave = __builtin_amdgcn_readfirstlane(C.tid >> 6); C.G = gridDim.x; C.bid = blockIdx.x;
    { const int t0_ = C.tid; C.tid = 0; C.lane = 0; if (t0_ < 64) ((volatile LAS unsigned*)(C.lds + LDS_MISC))[t0_] = 0u; }
    volatile LAS unsigned* misc = (volatile LAS unsigned*)(C.lds + LDS_MISC);
    __syncthreads();
    unsigned char* const ws0 = P.ws; float* const out0 = P.out;
    XcdBarrier bar; bar.bar = (unsigned*)(ws0 + WS_CTL) + CW_BAR; bar.x = 0; bar.st = misc;
#if MK_ONE_LAUNCH
    bar = xcd_barrier_post((unsigned*)(ws0 + WS_CTL) + CW_BAR, misc);
#endif
    const int lo = P.ph_lo, hi = P.ph_hi;
#ifndef SITE_ONLY
#define SITE_ONLY -1
#endif
#define SITE(n) (SITE_ONLY < 0 || SITE_ONLY == (n))
#define IN(k) (lo <= (k) && (k) < hi)
#define SEAM(k) do { if (IN(k) && IN((k) + 1)) xcd_barrier(bar); } while (0)
#define SEAM_L(k) do { if (IN(k) && IN((k) + 1)) { if (__builtin_amdgcn_readfirstlane((int)misc[3]) != 0) xcd_local_barrier(bar); else xcd_barrier(bar); } } while (0)
#define AP(OFF, W) ACT_TM(ws, C, OFF, W)

    enum { EV_D4 = 0, EV_D5, EV_D6, EV_D7, EV_D8, EV_RA, EV_RBC, EV_RDE };
#define LM() (__builtin_amdgcn_readfirstlane((int)misc[3]) != 0)
#define SEAM_S(k, s1, s2, rel) do { if (IN(k) && IN((k) + 1)) { if (LM()) xcd_local_barrier(bar, (s1), (s2), (rel)); else xcd_barrier(bar); } } while (0)
#define EV_WAIT(k, ev, tgt, acq) do { if (IN((k) - 1) && IN(k) && LM()) xcd_event_wait(bar, (ev), (unsigned)(tgt), (acq)); } while (0)
    int cur = 0;
    if constexpr (SITE(0)) if (IN(0)) { SITE_VARS
        phase_init(C, (const float*)(const GAS float*)P.in[0], (const int*)(const GAS int*)P.in[2], tabm, tabr, (bf16_t*)(ws + WS_HB0), (float*)(ws + WS_PSH0)); }
    if constexpr (SITE(1)) if (IN(1)) { SITE_VARS phase_prep(C, P.in, ws, 0, PREP_ALL, false); }
    SEAM(1);
#if MK_ONE_LAUNCH
    if (IN(1) && IN(2)) {
        if (LM()) C.bid = __builtin_amdgcn_readfirstlane((int)(misc[2] * 8u + bar.x));
    }
#endif
#pragma unroll 1
    for (int L = 0; L < DEPTH; ++L) {
        const int pb = 1 + 9 * L, j = L >> 1; const bool nxt = L + 1 < DEPTH;
        if (L >= 1) EV_WAIT(pb + 1, EV_RA, 8 * L, true);
        if ((L & 1) == 0) {
            if constexpr (SITE(2)) if (IN(pb + 1)) { SITE_VARS GEMM_PHASE(EpiE1, hbc, ws + WS_WMIX + WM_EIN, T, EINP, D, psc, (bf16_t*)AP(A_CQ, QL), (bf16_t*)AP(A_CKV, KVL), (bf16_t*)AP(A_KROT, 64), (bf16_t*)AP(A_UG, 1024), (bf16_t*)AP(A_VG, 1024), psq, pskv, psv, tabm, (PG8_LAS float*)(C.lds + LDS_XCH + 12288)); }
            SEAM_L(pb + 1);
            if constexpr (SITE(3)) if (IN(pb + 2)) { SITE_VARS
                GEMM_PHASE(EpiE2, AP(A_CQ, QL), ws + WS_WMIX + WM_QUP, T, QUPN, QL, psq, (bf16_t*)AP(A_Q, QUPN), tabm, (PG8_LAS float*)(C.lds + LDS_XCH + 12288));
                GEMM_PHASE(EpiE3k, AP(A_CKV, KVL), ws + WS_WMIX + WM_KVK, T, 1024, KVL, pskv, (bf16_t*)AP(A_KN, 1024), (PG8_LAS float*)(C.lds + LDS_XCH + 12288));
                GEMM_PHASE(EpiE3v, ws + WS_WMIX + WM_KVV, AP(A_CKV, KVL), 1024, T, KVL, pskv, (bf16_t*)ACT_VT(ws, C));
            }
            SEAM_L(pb + 2);
        } else {
            if constexpr (SITE(6)) if (IN(pb + 1)) { SITE_VARS GEMM_PHASE(EpiO1, hbc, ws + WS_WMIX + WM_RIN, T, RIN, D, psc, (bf16_t*)AP(A_RQ, 2048), (bf16_t*)AP(A_RK, 2048), (bf16_t*)AP(A_RVV, RV), (bf16_t*)AP(A_RSG, RV), tabr, (PG8_LAS float*)(C.lds + LDS_XCH + 12288)); }
            SEAM_L(pb + 1);
            if constexpr (SITE(7)) if (IN(pb + 2)) { SITE_VARS phase_ret(C, ws, true); }
            SEAM_L(pb + 2);
        }
        if (L >= 1) {
            EV_WAIT(pb + 3, EV_D7, 8 * L, false); EV_WAIT(pb + 3, EV_D8, 8 * L, false);
            if constexpr (SITE(1)) if (IN(pb + 3)) { SITE_VARS phase_prep(C, P.in, ws, L, PREP_FDN | PREP_PLEG, true); }
        }
        if ((L & 1) == 0) {
            if constexpr (SITE(4)) if (IN(pb + 3)) { SITE_VARS
                phase_attn(C, ws);
                phase_sgu(C, ws, (const float*)(const GAS float*)P.in[9] + (size_t)j * 1024, (const float*)(const GAS float*)P.in[10] + (size_t)j * 1024, (const float*)(const GAS float*)P.in[12] + (size_t)j * 1024);
            }
            SEAM_S(pb + 3, L >= 1 ? (int)EV_RDE : -1, -1, L >= 1);
            if constexpr (SITE(5)) if (IN(pb + 4)) { SITE_VARS GEMM_PHASE(EpiResid, AP(A_AB, D), ws + WS_WMIX + WM_EOUT, T, D, D, hbc, hbc, psc, (PG8_LAS float*)(C.lds + LDS_XCH)); }
        } else {
            if constexpr (SITE(8)) if (IN(pb + 3)) { SITE_VARS phase_retnorm(C, ws, (const float*)(const GAS float*)P.in[15] + (size_t)j * RV, (const float*)(const GAS float*)P.in[16] + (size_t)j * RV); }
            SEAM_S(pb + 3, L >= 1 ? (int)EV_RDE : -1, -1, L >= 1);
            if constexpr (SITE(9)) if (IN(pb + 4)) { SITE_VARS GEMM_PHASE(EpiResid, AP(A_RVV, RV), ws + WS_WMIX + WM_ROUT, T, D, RV, hbc, hbc, psc, (PG8_LAS float*)(C.lds + LDS_XCH)); }
        }
        SEAM_S(pb + 4, EV_D4, -1, false);
        if (L >= 1) EV_WAIT(pb + 5, EV_RBC, 8 * L, true);
        if constexpr (SITE(10)) if (IN(pb + 5)) { SITE_VARS
            GEMM_PHASE(EpiF1, hbc, ws + WS_WFFN + WF_UP, T, FF2, D, psc, (bf16_t*)AP(A_M, FF), (float*)(ws + WS_SIDE), (const float*)(const GAS float*)P.in[20] + (size_t)L * 3 * FF2, (const float*)(const GAS float*)P.in[21] + (size_t)L * FF2, (PG8_LAS float*)(C.lds + LDS_XCH)); }
        SEAM_S(pb + 5, EV_D5, -1, false);
        if (nxt) {
            EV_WAIT(pb + 6, EV_D4, 8 * (L + 1), false);
            if constexpr (SITE(1)) if (IN(pb + 6)) { SITE_VARS phase_prep(C, P.in, ws, L + 1, PREP_MIX, true); }
        }
        if constexpr (SITE(11)) if (IN(pb + 6)) { SITE_VARS
            phase_fixup(C, ws, (const float*)(const GAS float*)P.in[20] + (size_t)L * 3 * FF2, (const float*)(const GAS float*)P.in[21] + (size_t)L * FF2);
            GEMM_PHASE(EpiStore, ws + WS_PBF, ws + WS_WPLE + WP_U, T, D, PLE, (bf16_t*)AP(A_UPV, D), D);
        }
        SEAM_S(pb + 6, EV_D6, nxt ? (int)EV_RA : -1, nxt);
        if (L >= 1) EV_WAIT(pb + 7, EV_RDE, 8 * L, true);
        if constexpr (SITE(12)) if (IN(pb + 7)) { SITE_VARS GEMM_PHASE(EpiResid, AP(A_M, FF), ws + WS_WFFN + WF_DN, T, D, FF, hbc, hbc, psc, (PG8_LAS float*)(C.lds + LDS_XCH)); }
        SEAM_S(pb + 7, EV_D7, -1, false);
        if (nxt) {
            EV_WAIT(pb + 8, EV_D5, 8 * (L + 1), false); EV_WAIT(pb + 8, EV_D6, 8 * (L + 1), false);
            if constexpr (SITE(1)) if (IN(pb + 8)) { SITE_VARS phase_prep(C, P.in, ws, L + 1, PREP_FUP | PREP_PLEU, true); }
        }
        if constexpr (SITE(13)) if (IN(pb + 8)) { SITE_VARS GEMM_PHASE(EpiPle, hbc, ws + WS_WPLE + WP_G, T, D, D, hbc, (const bf16_t*)AP(A_UPV, D), hbn, psc, psn, (PG8_LAS float*)(C.lds + LDS_XCH), (PG8_LAS float*)(C.lds + LDS_XCH + 12288)); }
        SEAM_S(pb + 8, EV_D8, nxt ? (int)EV_RBC : -1, nxt);
        cur ^= 1;
    }
    if constexpr (SITE(14)) if (IN(NPHASE - 1)) { SITE_VARS phase_final(C, out, hbc, psc, (const float*)(const GAS float*)P.in[26]); }
#undef LM
#undef SEAM_S
#undef EV_WAIT
#undef IN
#undef SEAM
#undef SEAM_L
#undef AP
}

extern "C" void kernel_launch(void* const* d_in, const int* in_sizes, int n_in, void* d_out, int out_size, void* d_ws, size_t ws_size, hipStream_t stream) {
    static int grid = 0;
    if (grid == 0) {
        if (n_in != 27 || out_size != T * D || ws_size < WS_END) { fprintf(stderr, "kernel_launch: unexpected problem (n_in %d, out %d, ws %zu < %zu)\n", n_in, out_size, ws_size, (size_t)WS_END); grid = -1; return; }
        int dev = 0, cus = 0, per_cu = 0;
        if (hipGetDevice(&dev) != hipSuccess || hipDeviceGetAttribute(&cus, hipDeviceAttributeMultiprocessorCount, dev) != hipSuccess) { grid = -1; return; }
        if (hipFuncSetAttribute((const void*)fwd, hipFuncAttributeMaxDynamicSharedMemorySize, LDS_BYTES) != hipSuccess) { fprintf(stderr, "kernel_launch: hipFuncSetAttribute failed\n"); grid = -1; return; }
        if (hipOccupancyMaxActiveBlocksPerMultiprocessor(&per_cu, (const void*)fwd, 512, LDS_BYTES) != hipSuccess || per_cu < 1) fprintf(stderr, "kernel_launch: occupancy query says %d\n", per_cu);
        (void)hipGetLastError();
        grid = cus >= 8 ? cus - cus % 8 : 256;
    }
    if (grid < 0) return;
    if (hipMemsetAsync((char*)d_ws + WS_CTL, 0, CTL_ZERO_BYTES, stream) != hipSuccess) return;
    Params p{};
    for (int i = 0; i < 27; ++i) p.in[i] = d_in[i];
    p.out = (float*)d_out; p.ws = (unsigned char*)d_ws;
#if MK_ONE_LAUNCH
    p.ph_lo = 0; p.ph_hi = NPHASE;
    hipLaunchKernelGGL(fwd, dim3(grid), dim3(512), LDS_BYTES, stream, p);
#else
    for (int k = 0; k < NPHASE; ++k) { p.ph_lo = k; p.ph_hi = k + 1; hipLaunchKernelGGL(fwd, dim3(grid), dim3(512), LDS_BYTES, stream, p); }
#endif
    const hipError_t le = hipPeekAtLastError();
    if (le != hipSuccess) fprintf(stderr, "kernel_launch: launch failed: %s\n", hipGetErrorName(le));
}
```

```cpp
#include <hip/hip_runtime.h>
#include <cstdio>
#include <cstdint>

#ifndef MK_ONE_LAUNCH
#define MK_ONE_LAUNCH 1
#endif

#define LAS __attribute__((address_space(3)))
#define GAS __attribute__((address_space(1)))
typedef unsigned short bf16_t;
typedef short bf16x8 __attribute__((ext_vector_type(8)));
typedef float f32x4 __attribute__((ext_vector_type(4)));
typedef float f32x2 __attribute__((ext_vector_type(2)));
typedef float f32x16 __attribute__((ext_vector_type(16)));
typedef unsigned u32x4 __attribute__((ext_vector_type(4)));
typedef unsigned u32x2 __attribute__((ext_vector_type(2)));
typedef _Float16 f16v2 __attribute__((ext_vector_type(2)));

constexpr int NB = 16, SEQ = 2048, T = NB * SEQ, D = 2048, DEPTH = 4;
constexpr int QL = 512, KVL = 256, HM = 8, QKD = 192;
constexpr int EIN = 2880, EINP = 3072, QUPN = 1536;
constexpr int RIN = 12288, RV = 4096;
constexpr int FF = 5632, FF2 = 11264, PLE = 256;
constexpr float EPS = 1e-6f;

constexpr size_t MiB = 1u << 20;
constexpr size_t WS_CTL = 0, CTL_ZERO_BYTES = 65536;
constexpr size_t WS_TABM = 1 * MiB;
constexpr size_t WS_TABR = 9 * MiB;
constexpr size_t WS_PSH0 = 41 * MiB, WS_PSH1 = 45 * MiB;
constexpr size_t WS_PSQ = 49 * MiB;
constexpr size_t WS_PSKV = 50 * MiB;
constexpr size_t WS_PSV = 51 * MiB;
constexpr size_t WS_SIDE = 55 * MiB;
constexpr size_t WS_HB0 = 77 * MiB, WS_HB1 = 205 * MiB;
constexpr size_t WS_PBF = 333 * MiB;
constexpr size_t WS_WMIX = 349 * MiB;
constexpr size_t WS_WFFN = 413 * MiB;
constexpr size_t WS_WPLE = 479 * MiB;
constexpr size_t WS_ACT = 488 * MiB;
constexpr size_t WS_END = WS_ACT + 768 * MiB;
constexpr size_t WM_EIN = 0, WM_QUP = 12 * MiB, WM_KVK = 14 * MiB, WM_KVV = 15 * MiB, WM_EOUT = 16 * MiB, WM_WS = 24 * MiB;
constexpr size_t WM_RIN = 0, WM_ROUT = 48 * MiB;
constexpr size_t WF_UP = 0, WF_DN = 44 * MiB, WP_G = 0, WP_U = 8 * MiB;
constexpr size_t A_CQ = 0, A_CKV = 32 * MiB, A_KROT = 48 * MiB, A_UG = 52 * MiB, A_VG = 116 * MiB, A_Q = 180 * MiB, A_KN = 276 * MiB, A_VT = 340 * MiB, A_AB = 404 * MiB;
constexpr size_t A_RQ = 0, A_RK = 128 * MiB, A_RVV = 256 * MiB, A_RSG = 512 * MiB;
constexpr size_t A_M = 0, A_UPV = 384 * MiB;
constexpr int CW_BAR = 4096;
constexpr size_t SLAB = 96 * MiB;
constexpr int VTP = T / 8;

constexpr int LDS_BYTES = 163840;
constexpr int LDS_XCH = 131072;
constexpr int LDS_MISC = 163840 - 256;

#define LDS_WAIT() asm volatile("s_waitcnt lgkmcnt(0)" ::: "memory")
#define VM_WAIT() asm volatile("s_waitcnt vmcnt(0)" ::: "memory")
__device__ __forceinline__ unsigned f2bf(float f) { unsigned u = __float_as_uint(f); return (u + 0x7fffu + ((u >> 16) & 1u)) >> 16; }
typedef __bf16 bf16v2 __attribute__((ext_vector_type(2)));
__device__ __forceinline__ unsigned pk2(float lo, float hi) { const f32x2 v = {lo, hi}; return __builtin_bit_cast(unsigned, __builtin_convertvector(v, bf16v2)); }
__device__ __forceinline__ float bf_lo(unsigned w) { return __uint_as_float(w << 16); }
__device__ __forceinline__ float bf_hi(unsigned w) { return __uint_as_float(w & 0xffff0000u); }
__device__ __forceinline__ float fexp2(float x) { return __builtin_amdgcn_exp2f(x); }
__device__ __forceinline__ float frcp(float x) { return __builtin_amdgcn_rcpf(x); }
__device__ __forceinline__ float gelu_t(float x) { const float t = x * (-2.302208198f - 0.1029432397f * (x * x)); return x * frcp(1.0f + fexp2(t)); }
__device__ __forceinline__ f32x2 gelu_t2(f32x2 x) { const f32x2 c0 = {-2.302208198f, -2.302208198f}, c1 = {-0.1029432397f, -0.1029432397f}, one = {1.0f, 1.0f};
    const f32x2 t = x * (c0 + c1 * (x * x)); f32x2 e; e[0] = fexp2(t[0]); e[1] = fexp2(t[1]); const f32x2 d = one + e; f32x2 r; r[0] = frcp(d[0]); r[1] = frcp(d[1]); return x * r; }
__device__ __forceinline__ f32x2 sigmoid_f2(f32x2 x) { const f32x2 k = {-1.442695041f, -1.442695041f}, one = {1.0f, 1.0f}; const f32x2 t = x * k; f32x2 e; e[0] = fexp2(t[0]); e[1] = fexp2(t[1]);
    const f32x2 d = one + e; f32x2 r; r[0] = frcp(d[0]); r[1] = frcp(d[1]); return r; }
__device__ __forceinline__ float sigmoid_f(float x) { return frcp(1.0f + fexp2(-1.442695041f * x)); }
__device__ __forceinline__ float dot4(f32x4 a) { return (a[0] * a[0] + a[1] * a[1]) + (a[2] * a[2] + a[3] * a[3]); }
__device__ __forceinline__ float sum4(f32x4 a) { return (a[0] + a[1]) + (a[2] + a[3]); }
__device__ __forceinline__ u32x4 pack8(f32x4 a, f32x4 b) { u32x4 w; w.x = pk2(a[0], a[1]); w.y = pk2(a[2], a[3]); w.z = pk2(b[0], b[1]); w.w = pk2(b[2], b[3]); return w; }
template <int CTRL> __device__ __forceinline__ float dppf(float v) { return __int_as_float(__builtin_amdgcn_mov_dpp(__float_as_int(v), CTRL, 0xf, 0xf, true)); }
template <int CTRL> __device__ __forceinline__ f32x4 dpp4(f32x4 v) { f32x4 r; r[0] = dppf<CTRL>(v[0]); r[1] = dppf<CTRL>(v[1]); r[2] = dppf<CTRL>(v[2]); r[3] = dppf<CTRL>(v[3]); return r; }
__device__ __forceinline__ float wave_sum(float v) {
#pragma unroll
    for (int o = 1; o < 64; o <<= 1) v += __shfl_xor(v, o);
    return v;
}

__device__ __forceinline__ int lane_id_now() { int l; asm volatile("v_mbcnt_lo_u32_b32 %0, -1, 0\n\tv_mbcnt_hi_u32_b32 %0, -1, %0" : "=v"(l)); return l; }
namespace pg8 {
#define PG8_LAS __attribute__((address_space(3)))
typedef unsigned short bf16_t;
typedef short bf16x8 __attribute__((ext_vector_type(8)));
typedef float f32x4 __attribute__((ext_vector_type(4)));
typedef unsigned u32x4 __attribute__((ext_vector_type(4)));
constexpr int BM = 256, BK = 64, HALF = 128, HTB = HALF * BK * 2  , STAGE_BYTES = 8 * HTB, NXCD = 8, WGM = 8;

__host__ __device__ __forceinline__ int lds_byte(int r, int c) { const int st = (r >> 4) * 2 + (c >> 5), rr = r & 15, cc = c & 31, ob = rr * 64 + cc * 2; return st * 1024 + (ob ^ (((ob >> 9) & 1) << 5)); }
__host__ __device__ __forceinline__ void stage_rc(int b, int& R, int& C) { const int st = b / 1024, sb = b % 1024, swz = sb ^ (((sb >> 9) & 1) << 5); R = (st >> 1) * 16 + swz / 64; C = (st & 1) * 32 + (swz % 64) / 2; }
__host__ __device__ __forceinline__ int perm32(int rho) { const int n = rho >> 4, i = rho & 15; return 8 * (i >> 2) + 4 * n + (i & 3); }

struct Unit { int pm, pn; };
struct Gemm { const bf16_t* A; const bf16_t* Bt; int M, N, K; };

struct StaticOrder {
    int nM, nN, nwg, G, c;
    __host__ __device__ void init(int M, int N, int G_, int c_) { nM = M / BM; nN = N / BM; nwg = nM * nN; G = G_; c = c_; }
    __host__ __device__ bool next(int i, Unit& u) const {
        const long L = (long)i * G + c; if (L >= nwg) return false;
        int wgid = (int)L; { const int q = nwg / NXCD, r = nwg % NXCD, xcd = wgid % NXCD, off = wgid / NXCD; wgid = (xcd < r ? xcd * (q + 1) : r * (q + 1) + (xcd - r) * q) + off; }
        const int nig = WGM * nN, gid = wgid / nig, fm = gid * WGM, gsz = (nM - fm) < WGM ? (nM - fm) : WGM;
        u.pm = fm + ((wgid % nig) % gsz); u.pn = (wgid % nig) / gsz; return true;
    }
    __device__ __forceinline__ void a_ready(const Unit&) const {}
    __device__ __forceinline__ void done(const Unit&) const {}
};


#define EPI_FENCE() asm volatile("" ::: "memory")
#define EPI_ROWS(ai, m) _Pragma("unroll") for (int ai = 0; ai < 2; ++ai) _Pragma("unroll") for (int m = 0; m < 4; ++m)
template <int NP> __device__ __forceinline__ void load_rstd(const float* ps, int rowb, int fq, float inv_dim, float (&rs)[2][4]) {
    float s[2][4];
    EPI_ROWS(ai, m) {
        const float* p = ps + (size_t)(rowb + ai * 128 + m * 16) * NP + fq * (NP / 4);
        if constexpr (NP == 8) { const f32x2 a = *(const GAS f32x2*)p; s[ai][m] = a[0] + a[1]; } else s[ai][m] = *(const GAS float*)p;
    }
    EPI_ROWS(ai, m) { float t = s[ai][m]; t += __shfl_xor(t, 16); t += __shfl_xor(t, 32); rs[ai][m] = rsqrtf(t * inv_dim + EPS); }
}
template <int NP> __device__ __forceinline__ void ps_dma(const float* ps, PG8_LAS float* psl, const Unit& u, int wr, int wc, int fr, int fq) {
    const int wid = wr * 4 + wc, lane = fq * 16 + fr;
    if (NP == 8 || wid < 4) __builtin_amdgcn_global_load_lds((const unsigned*)(ps + (size_t)u.pm * BM * NP + (wid * 64 + lane) * 4), (PG8_LAS unsigned*)(psl + wid * 256), 16, 0, 0);
}
template <int NP> __device__ __forceinline__ void lds_rstd(const PG8_LAS float* psl, int wr, int fr, float inv_dim, float (&rs)[2][4]) {
    EPI_ROWS(ai, m) { const PG8_LAS float* p = psl + (ai * 128 + wr * 64 + m * 16 + fr) * NP; float t;
        if constexpr (NP == 8) { const f32x4 a = *(const PG8_LAS f32x4*)p, b = *(const PG8_LAS f32x4*)(p + 4); t = sum4(a) + sum4(b); } else { const f32x4 a = *(const PG8_LAS f32x4*)p; t = sum4(a); }
        rs[ai][m] = rsqrtf(t * inv_dim + EPS); }
}
struct NoPre {};
__device__ __forceinline__ void rope8(f32x4 t0, f32x4 t1, f32x4 t2, f32x4 t3, f32x4 x1a, f32x4 x1b, f32x4 x2a, f32x4 x2b, float sc, u32x4& o1, u32x4& o2) {
    x1a *= sc; x1b *= sc; x2a *= sc; x2b *= sc;
    f32x4 ra, rb, qa, qb;
    ra[0] = x1a[0] * t0[0] - x2a[0] * t0[1]; qa[0] = x2a[0] * t0[0] + x1a[0] * t0[1];
    ra[1] = x1a[1] * t0[2] - x2a[1] * t0[3]; qa[1] = x2a[1] * t0[2] + x1a[1] * t0[3];
    ra[2] = x1a[2] * t1[0] - x2a[2] * t1[1]; qa[2] = x2a[2] * t1[0] + x1a[2] * t1[1];
    ra[3] = x1a[3] * t1[2] - x2a[3] * t1[3]; qa[3] = x2a[3] * t1[2] + x1a[3] * t1[3];
    rb[0] = x1b[0] * t2[0] - x2b[0] * t2[1]; qb[0] = x2b[0] * t2[0] + x1b[0] * t2[1];
    rb[1] = x1b[1] * t2[2] - x2b[1] * t2[3]; qb[1] = x2b[1] * t2[2] + x1b[1] * t2[3];
    rb[2] = x1b[2] * t3[0] - x2b[2] * t3[1]; qb[2] = x2b[2] * t3[0] + x1b[2] * t3[1];
    rb[3] = x1b[3] * t3[2] - x2b[3] * t3[3]; qb[3] = x2b[3] * t3[2] + x1b[3] * t3[3];
    o1 = pack8(ra, rb); o2 = pack8(qa, qb);
}
__device__ __forceinline__ void row_ss_reduce(PG8_LAS float* red, float* ps, const float (&ss)[2][4], const Unit& u, int wr, int wc, int fr, int fq) {
    if (fq == 0) { EPI_ROWS(ai, m) red[(ai * HALF + wr * 64 + m * 16 + fr) * 4 + wc] = ss[ai][m]; }
    asm volatile("s_waitcnt lgkmcnt(0)" ::: "memory"); __builtin_amdgcn_s_barrier(); asm volatile("" ::: "memory");
    const int t = wr * 256 + wc * 64 + fq * 16 + fr;
    if (t < 256) { const f32x4 v = *(const PG8_LAS f32x4*)(red + t * 4); *(GAS float*)(ps + (size_t)(u.pm * BM + t) * 8 + u.pn) = sum4(v); }
}

__device__ __forceinline__ void unpack8(u32x4 w, f32x4& a, f32x4& b) { a[0] = bf_lo(w.x); a[1] = bf_hi(w.x); a[2] = bf_lo(w.y); a[3] = bf_hi(w.y); b[0] = bf_lo(w.z); b[1] = bf_hi(w.z); b[2] = bf_lo(w.w); b[3] = bf_hi(w.w); }
struct EpiResid {
    static constexpr bool PERM = true, AFTER_DRAIN = false;
    typedef NoPre Pre; __device__ __forceinline__ void prefetch(Pre&, const Unit&, int, int, int, int) const {}
    const bf16_t* hin; bf16_t* hb; float* ps; PG8_LAS float* red;
    __device__ __forceinline__ void operator()(f32x4 (&acc)[2][2][4][2], const Unit& u, int wr, int wc, int fr, int fq, const Pre& pre) const {
        asm volatile("" : "+v"(fr), "+v"(fq));
        const int row0 = u.pm * BM + wr * 64 + fr, col0 = u.pn * BM + wc * 32 + 8 * fq;
        float ssr[2][4];
#pragma unroll
        for (int ai = 0; ai < 2; ++ai) {
            u32x4 bv[4][2];
#pragma unroll
            for (int m = 0; m < 4; ++m)
#pragma unroll
                for (int bj = 0; bj < 2; ++bj) bv[m][bj] = *(const GAS u32x4*)(hin + (size_t)(row0 + ai * HALF + m * 16) * D + col0 + bj * HALF);
#pragma unroll
            for (int m = 0; m < 4; ++m) {
                const size_t off = (size_t)(row0 + ai * HALF + m * 16) * D + col0; float ss = 0.f;
#pragma unroll
                for (int bj = 0; bj < 2; ++bj) {
                    f32x4 b0, b1; unpack8(bv[m][bj], b0, b1);
                    const f32x4 v0 = acc[ai][bj][m][0] + b0, v1 = acc[ai][bj][m][1] + b1;
                    *(GAS u32x4*)(hb + off + bj * HALF) = pack8(v0, v1); ss += dot4(v0) + dot4(v1);
                }
                ss += __shfl_xor(ss, 16); ss += __shfl_xor(ss, 32); ssr[ai][m] = ss;
            }
            EPI_FENCE();
        }
        row_ss_reduce(red, ps, ssr, u, wr, wc, fr, fq);
    }
};
struct EpiPle {
    static constexpr bool PERM = true, AFTER_DRAIN = false;
    typedef NoPre Pre; __device__ __forceinline__ void prefetch(Pre&, const Unit& u, int wr, int wc, int fr, int fq) const { asm volatile("" : "+v"(fr), "+v"(fq)); ps_dma<8>(ps_in, psl, u, wr, wc, fr, fq); }
    const bf16_t* hin; const bf16_t* upv; bf16_t* hb; const float* ps_in; float* ps_out; PG8_LAS float* red; PG8_LAS float* psl;
    __device__ __forceinline__ void operator()(f32x4 (&acc)[2][2][4][2], const Unit& u, int wr, int wc, int fr, int fq, const Pre& pre) const {
        asm volatile("" : "+v"(fr), "+v"(fq));
        const int row0 = u.pm * BM + wr * 64 + fr, col0 = u.pn * BM + wc * 32 + 8 * fq;
        float rs[2][4]; lds_rstd<8>(psl, wr, fr, 1.0f / D, rs);
        float ssr[2][4];
#pragma unroll
        for (int ai = 0; ai < 2; ++ai) {
            u32x4 bv[4][2], uv[4][2];
#pragma unroll
            for (int m = 0; m < 4; ++m)
#pragma unroll
                for (int bj = 0; bj < 2; ++bj) { const size_t off = (size_t)(row0 + ai * HALF + m * 16) * D + col0 + bj * HALF; bv[m][bj] = *(const GAS u32x4*)(hin + off); uv[m][bj] = *(const GAS u32x4*)(upv + off); }
#pragma unroll
            for (int m = 0; m < 4; ++m) {
                const size_t off = (size_t)(row0 + ai * HALF + m * 16) * D + col0; float ss = 0.f; const float r = rs[ai][m];
#pragma unroll
                for (int bj = 0; bj < 2; ++bj) {
                    f32x4 v0, v1, u0, u1; unpack8(bv[m][bj], v0, v1); unpack8(uv[m][bj], u0, u1);
                    const f32x4 a0 = acc[ai][bj][m][0] * r, a1 = acc[ai][bj][m][1] * r;
#pragma unroll
                    for (int h = 0; h < 2; ++h) {
                        const f32x2 s0 = sigmoid_f2((f32x2){a0[2 * h], a0[2 * h + 1]}), s1 = sigmoid_f2((f32x2){a1[2 * h], a1[2 * h + 1]});
                        const f32x2 w0 = (f32x2){v0[2 * h], v0[2 * h + 1]} + (f32x2){u0[2 * h], u0[2 * h + 1]} * s0, w1 = (f32x2){v1[2 * h], v1[2 * h + 1]} + (f32x2){u1[2 * h], u1[2 * h + 1]} * s1;
                        v0[2 * h] = w0[0]; v0[2 * h + 1] = w0[1]; v1[2 * h] = w1[0]; v1[2 * h + 1] = w1[1]; }
                    *(GAS u32x4*)(hb + off + bj * HALF) = pack8(v0, v1); ss += dot4(v0) + dot4(v1);
                }
                ss += __shfl_xor(ss, 16); ss += __shfl_xor(ss, 32); ssr[ai][m] = ss;
            }
            EPI_FENCE();
        }
        row_ss_reduce(red, ps_out, ssr, u, wr, wc, fr, fq);
    }
};
struct EpiStore {
    static constexpr bool PERM = true, AFTER_DRAIN = false;
    typedef NoPre Pre; __device__ __forceinline__ void prefetch(Pre&, const Unit&, int, int, int, int) const {}
    bf16_t* o; int ldc;
    __device__ __forceinline__ void operator()(f32x4 (&acc)[2][2][4][2], const Unit& u, int wr, int wc, int fr, int fq, const Pre& pre) const {
        asm volatile("" : "+v"(fr), "+v"(fq));
        const int row0 = u.pm * BM + wr * 64 + fr, col0 = u.pn * BM + wc * 32 + 8 * fq;
        EPI_ROWS(ai, m) {
            const size_t off = (size_t)(row0 + ai * HALF + m * 16) * ldc + col0;
#pragma unroll
            for (int bj = 0; bj < 2; ++bj) *(GAS u32x4*)(o + off + bj * HALF) = pack8(acc[ai][bj][m][0], acc[ai][bj][m][1]);
        }
    }
};
__device__ __forceinline__ f32x4 h2x2_f32(unsigned w0, unsigned w1) { const f16v2 a = __builtin_bit_cast(f16v2, w0), b = __builtin_bit_cast(f16v2, w1); return (f32x4){(float)a[0], (float)a[1], (float)b[0], (float)b[1]}; }
template <bool TABH> __device__ __forceinline__ void rope_tile(f32x4 (&acc)[2][2][4][2], const float (&rs)[2][4], float sc, const float* tab, int tpitch, int tcol, bf16_t* d1, bf16_t* d2, size_t dpitch, int row0) {
#pragma unroll
    for (int ai = 0; ai < 2; ++ai)
#pragma unroll
        for (int mp = 0; mp < 2; ++mp) {
            f32x4 tv[2][4]; u32x4 tw[2][2];
#pragma unroll
            for (int mm = 0; mm < 2; ++mm) {
                if constexpr (TABH) { const GAS u32x4* tp = (const GAS u32x4*)((const unsigned*)tab + (size_t)(row0 + ai * HALF + (2 * mp + mm) * 16) * tpitch + tcol); tw[mm][0] = tp[0]; tw[mm][1] = tp[1]; }
                else { const GAS f32x4* tp = (const GAS f32x4*)(tab + ((size_t)(row0 + ai * HALF + (2 * mp + mm) * 16) * tpitch + tcol) * 2); tv[mm][0] = tp[0]; tv[mm][1] = tp[1]; tv[mm][2] = tp[2]; tv[mm][3] = tp[3]; }
            }
#pragma unroll
            for (int mm = 0; mm < 2; ++mm) { const int m = 2 * mp + mm; const size_t row = (size_t)(row0 + ai * HALF + m * 16); u32x4 o1, o2;
                if constexpr (TABH) { tv[mm][0] = h2x2_f32(tw[mm][0].x, tw[mm][0].y); tv[mm][1] = h2x2_f32(tw[mm][0].z, tw[mm][0].w); tv[mm][2] = h2x2_f32(tw[mm][1].x, tw[mm][1].y); tv[mm][3] = h2x2_f32(tw[mm][1].z, tw[mm][1].w); }
                rope8(tv[mm][0], tv[mm][1], tv[mm][2], tv[mm][3], acc[ai][0][m][0], acc[ai][0][m][1], acc[ai][1][m][0], acc[ai][1][m][1], rs[ai][m] * sc, o1, o2);
                *(GAS u32x4*)(d1 + row * dpitch) = o1; *(GAS u32x4*)(d2 + row * dpitch) = o2; }
            EPI_FENCE();
        }
}
struct EpiE1 {
    static constexpr bool PERM = true, AFTER_DRAIN = false;
    typedef NoPre Pre; __device__ __forceinline__ void prefetch(Pre&, const Unit& u, int wr, int wc, int fr, int fq) const { asm volatile("" : "+v"(fr), "+v"(fq)); ps_dma<8>(ps, psl, u, wr, wc, fr, fq); }
    const float* ps; bf16_t *cq, *ckv, *krot, *ug, *vg; float *psq, *pskv, *psv; const float* tabm; PG8_LAS float* psl;
    __device__ __forceinline__ void operator()(f32x4 (&acc)[2][2][4][2], const Unit& u, int wr, int wc, int fr, int fq, const Pre& pre) const {
        asm volatile("" : "+v"(fr), "+v"(fq));
        const int row0 = u.pm * BM + wr * 64 + fr, cw = wc * 32 + 8 * fq, pn = u.pn;
        float rs[2][4]; lds_rstd<8>(psl, wr, fr, 1.0f / D, rs);
        if (pn < 2) {
            EPI_ROWS(ai, m) {
                const int row = row0 + ai * HALF + m * 16; const float r = rs[ai][m]; float ss = 0.f;
#pragma unroll
                for (int bj = 0; bj < 2; ++bj) { const f32x4 v0 = acc[ai][bj][m][0] * r, v1 = acc[ai][bj][m][1] * r;
                    *(GAS u32x4*)(cq + (size_t)row * QL + pn * 256 + bj * HALF + cw) = pack8(v0, v1); ss += dot4(v0) + dot4(v1); }
                ss += __shfl_xor(ss, 16); ss += __shfl_xor(ss, 32);
                if (fq == 0) *(GAS float*)(psq + (size_t)row * 8 + pn * 4 + wc) = ss;
                EPI_FENCE();
            }
        } else if (pn == 2) {
            EPI_ROWS(ai, m) {
                const int row = row0 + ai * HALF + m * 16; const float r = rs[ai][m]; float ss = 0.f;
#pragma unroll
                for (int bj = 0; bj < 2; ++bj) { const f32x4 v0 = acc[ai][bj][m][0] * r, v1 = acc[ai][bj][m][1] * r;
                    *(GAS u32x4*)(ckv + (size_t)row * KVL + bj * HALF + cw) = pack8(v0, v1); ss += dot4(v0) + dot4(v1); }
                ss += __shfl_xor(ss, 16); ss += __shfl_xor(ss, 32);
                if (fq == 0) *(GAS float*)(pskv + (size_t)row * 4 + wc) = ss;
                EPI_FENCE();
            }
        } else if (pn < 11) {
            const bool isv = pn >= 7; bf16_t* dst = isv ? vg : ug; const int colt = (isv ? pn - 7 : pn - 3) * 256;
            EPI_ROWS(ai, m) {
                const int row = row0 + ai * HALF + m * 16; const float r = rs[ai][m]; float s1 = 0.f, s2 = 0.f;
#pragma unroll
                for (int bj = 0; bj < 2; ++bj) { f32x4 v0 = acc[ai][bj][m][0] * r, v1 = acc[ai][bj][m][1] * r;
                    if (isv) {
#pragma unroll
                        for (int i = 0; i < 4; ++i) { v0[i] = gelu_t(v0[i]); v1[i] = gelu_t(v1[i]); } }
                    *(GAS u32x4*)(dst + (size_t)row * 1024 + colt + bj * HALF + cw) = pack8(v0, v1); s1 += sum4(v0) + sum4(v1); s2 += dot4(v0) + dot4(v1); }
                if (isv) { s1 += __shfl_xor(s1, 16); s1 += __shfl_xor(s1, 32); s2 += __shfl_xor(s2, 16); s2 += __shfl_xor(s2, 32);
                    if (fq == 0) *(GAS f32x2*)(psv + ((size_t)row * 16 + (pn - 7) * 4 + wc) * 2) = (f32x2){s1, s2}; }
                EPI_FENCE();
            }
        } else if (wc == 0) {
            rope_tile<false>(acc, rs, 1.0f, tabm, 32, 8 * fq, krot + 8 * fq, krot + 32 + 8 * fq, 64, row0);
        }
    }
};
struct EpiE2 {
    static constexpr bool PERM = true, AFTER_DRAIN = false;
    typedef NoPre Pre; __device__ __forceinline__ void prefetch(Pre&, const Unit& u, int wr, int wc, int fr, int fq) const { asm volatile("" : "+v"(fr), "+v"(fq)); ps_dma<8>(ps, psl, u, wr, wc, fr, fq); }
    const float* ps; bf16_t* q; const float* tabm; PG8_LAS float* psl;
    __device__ __forceinline__ void operator()(f32x4 (&acc)[2][2][4][2], const Unit& u, int wr, int wc, int fr, int fq, const Pre& pre) const {
        asm volatile("" : "+v"(fr), "+v"(fq));
        const int row0 = u.pm * BM + wr * 64 + fr, pn = u.pn;
        float rs[2][4]; lds_rstd<8>(psl, wr, fr, 1.0f / QL, rs);
        constexpr float QSC = 0.10411754f;
        if (pn < 4) {
            EPI_ROWS(ai, m) { const int row = row0 + ai * HALF + m * 16; const float r = rs[ai][m] * QSC;
#pragma unroll
                for (int bj = 0; bj < 2; ++bj) *(GAS u32x4*)(q + (size_t)row * QUPN + (2 * pn + bj) * QKD + wc * 32 + 8 * fq) = pack8(acc[ai][bj][m][0] * r, acc[ai][bj][m][1] * r); }
        } else {
            bf16_t* d = q + (4 * (pn - 4) + wc) * QKD + 128 + 8 * fq;
            rope_tile<false>(acc, rs, QSC, tabm, 32, 8 * fq, d, d + 32, QUPN, row0);
        }
    }
};
struct EpiE3k {
    static constexpr bool PERM = true, AFTER_DRAIN = false;
    typedef NoPre Pre; __device__ __forceinline__ void prefetch(Pre&, const Unit& u, int wr, int wc, int fr, int fq) const { asm volatile("" : "+v"(fr), "+v"(fq)); ps_dma<4>(ps, psl, u, wr, wc, fr, fq); }
    const float* ps; bf16_t* kn; PG8_LAS float* psl;
    __device__ __forceinline__ void operator()(f32x4 (&acc)[2][2][4][2], const Unit& u, int wr, int wc, int fr, int fq, const Pre& pre) const {
        asm volatile("" : "+v"(fr), "+v"(fq));
        const int row0 = u.pm * BM + wr * 64 + fr;
        float rs[2][4]; lds_rstd<4>(psl, wr, fr, 1.0f / KVL, rs);
        EPI_ROWS(ai, m) { const int row = row0 + ai * HALF + m * 16; const float r = rs[ai][m];
#pragma unroll
            for (int bj = 0; bj < 2; ++bj) *(GAS u32x4*)(kn + (size_t)row * 1024 + (2 * u.pn + bj) * 128 + wc * 32 + 8 * fq) = pack8(acc[ai][bj][m][0] * r, acc[ai][bj][m][1] * r); }
    }
};
struct EpiE3v {
    static constexpr bool PERM = true, AFTER_DRAIN = false;
    typedef NoPre Pre; __device__ __forceinline__ void prefetch(Pre&, const Unit&, int, int, int, int) const {}
    const float* ps; bf16_t* vt;
    __device__ __forceinline__ void operator()(f32x4 (&acc)[2][2][4][2], const Unit& u, int wr, int wc, int fr, int fq, const Pre& pre) const {
        asm volatile("" : "+v"(fr), "+v"(fq));
        const int row0 = u.pm * BM + wr * 64 + fr, t0 = u.pn * BM + wc * 32 + 8 * fq;
        f32x4 cs[2][2];
#pragma unroll
        for (int bj = 0; bj < 2; ++bj)
#pragma unroll
            for (int n = 0; n < 2; ++n)
#pragma unroll
                for (int i = 0; i < 4; ++i) { const f32x4 p = *(const GAS f32x4*)(ps + (size_t)(t0 + bj * HALF + 4 * n + i) * 4); cs[bj][n][i] = rsqrtf(sum4(p) * (1.0f / KVL) + EPS); }
        EPI_ROWS(ai, m) { const int row = row0 + ai * HALF + m * 16;
#pragma unroll
            for (int bj = 0; bj < 2; ++bj) *(GAS u32x4*)(vt + (size_t)row * VTP + t0 + bj * HALF) = pack8(acc[ai][bj][m][0] * cs[bj][0], acc[ai][bj][m][1] * cs[bj][1]); }
    }
};
struct EpiO1 {
    static constexpr bool PERM = true, AFTER_DRAIN = false;
    typedef NoPre Pre; __device__ __forceinline__ void prefetch(Pre&, const Unit& u, int wr, int wc, int fr, int fq) const { asm volatile("" : "+v"(fr), "+v"(fq)); ps_dma<8>(ps, psl, u, wr, wc, fr, fq); }
    const float* ps; bf16_t *rq, *rk, *rv, *rsg; const float* tabr; PG8_LAS float* psl;
    __device__ __forceinline__ void operator()(f32x4 (&acc)[2][2][4][2], const Unit& u, int wr, int wc, int fr, int fq, const Pre& pre) const {
        asm volatile("" : "+v"(fr), "+v"(fq));
        const int row0 = u.pm * BM + wr * 64 + fr, cw = wc * 32 + 8 * fq, pn = u.pn;
        float rs[2][4]; lds_rstd<8>(psl, wr, fr, 1.0f / D, rs);
        if (pn < 16) {
            bf16_t* dst = (pn < 8 ? rq : rk) + (pn & 7) * 256 + cw;
            rope_tile<true>(acc, rs, pn < 8 ? 1.0f : 0.0625f, tabr, 128, cw, dst, dst + 128, 2048, row0);
        } else {
            bf16_t* dst = (pn < 32 ? rv + (pn - 16) * 256 : rsg + (pn - 32) * 256) + cw;
            EPI_ROWS(ai, m) { const int row = row0 + ai * HALF + m * 16; const float r = rs[ai][m];
#pragma unroll
                for (int bj = 0; bj < 2; ++bj) *(GAS u32x4*)(dst + (size_t)row * RV + bj * HALF) = pack8(acc[ai][bj][m][0] * r, acc[ai][bj][m][1] * r); }
        }
    }
};
struct EpiF1 {
    static constexpr bool PERM = true, AFTER_DRAIN = false;
    typedef NoPre Pre;
    __device__ __forceinline__ void prefetch(Pre&, const Unit& u, int wr, int wc, int fr, int fq) const { asm volatile("" : "+v"(fr), "+v"(fq));
        PG8_LAS float* psl = xl + 3072;
        ps_dma<8>(ps, psl, u, wr, wc, fr, fq);
        const int wid = wr * 4 + wc, lane = fq * 16 + fr;
        if (wid < 4) { const int c4 = lane * 4, wch = (c4 >> 7) * FF + u.pn * HALF + (c4 & 127);
            __builtin_amdgcn_global_load_lds((const unsigned*)((wid < 3 ? cw3 + wid * FF2 : cb) + wch), (PG8_LAS unsigned*)(xl + 2048 + wid * 256), 16, 0, 0); } }
    const float* ps; bf16_t* mo; float* side; const float* cw3; const float* cb; PG8_LAS float* xl;
    __device__ __forceinline__ void operator()(f32x4 (&acc)[2][2][4][2], const Unit& u, int wr, int wc, int fr, int fq, const Pre& pre) const {
        asm volatile("" : "+v"(fr), "+v"(fq));
        const int row0 = u.pm * BM + wr * 64 + fr, jc = wc * 32 + 8 * fq;
        PG8_LAS float* wl = xl + 2048;
        float rs[2][4]; lds_rstd<8>(xl + 3072, wr, fr, 1.0f / D, rs);
        EPI_ROWS(ai, m) { const float r = rs[ai][m];
#pragma unroll
            for (int bj = 0; bj < 2; ++bj) { acc[ai][bj][m][0] *= r; acc[ai][bj][m][1] *= r; } }
        EPI_FENCE();
        if (fr >= 14) {
#pragma unroll
            for (int ai = 0; ai < 2; ++ai)
#pragma unroll
                for (int bj = 0; bj < 2; ++bj)
#pragma unroll
                    for (int n = 0; n < 2; ++n) *(PG8_LAS f32x4*)(xl + ((ai * 2 + wr) * 2 + (fr - 14)) * 256 + bj * HALF + jc + 4 * n) = acc[ai][bj][3][n];
        }
        if (wr == 0 && fr < 2) {
#pragma unroll
            for (int bj = 0; bj < 2; ++bj)
#pragma unroll
                for (int n = 0; n < 2; ++n) *(GAS f32x4*)(side + ((size_t)(u.pm * 4 + fr)) * FF2 + bj * FF + u.pn * HALF + jc + 4 * n) = acc[0][bj][0][n];
        }
        if (wr == 1 && fr >= 14) {
#pragma unroll
            for (int bj = 0; bj < 2; ++bj)
#pragma unroll
                for (int n = 0; n < 2; ++n) *(GAS f32x4*)(side + ((size_t)(u.pm * 4 + 2 + fr - 14)) * FF2 + bj * FF + u.pn * HALF + jc + 4 * n) = acc[1][bj][3][n];
        }
        asm volatile("s_waitcnt lgkmcnt(0)" ::: "memory"); __builtin_amdgcn_s_barrier(); asm volatile("" ::: "memory");
#pragma unroll
        for (int bjj = 0; bjj < 2; ++bjj)
#pragma unroll
            for (int n = 0; n < 2; ++n) {
                const int bj = 1 - bjj;
                const int lc = bj * HALF + jc + 4 * n;
                const f32x4 w0 = *(const PG8_LAS f32x4*)(wl + lc), w1 = *(const PG8_LAS f32x4*)(wl + 256 + lc), w2 = *(const PG8_LAS f32x4*)(wl + 512 + lc), bb = *(const PG8_LAS f32x4*)(wl + 768 + lc);
                const float m1 = fr >= 1 ? 1.f : 0.f, m2 = fr >= 2 ? 1.f : 0.f;
                const f32x4 w1a = w1 * m1, w1b = w1 - w1a, w0a = w0 * m2, w0b = w0 - w0a;
#pragma unroll
                for (int ai = 0; ai < 2; ++ai) {
                    const int src = ai * 2 + wr - 1;
                    const int srcc = src < 0 ? 0 : src; const float hz = src < 0 ? 0.f : 1.f;
                    asm volatile("" : "+v"(acc[ai][bj][0][n]), "+v"(acc[ai][bj][1][n]), "+v"(acc[ai][bj][2][n]), "+v"(acc[ai][bj][3][n]));
#pragma unroll
                    for (int mm = 0; mm < 4; ++mm) {
                        const int m = 3 - mm;
                        const f32x4 cur = acc[ai][bj][m][n];
                        f32x4 r1p, r2p;
                        if (m > 0) { r1p = dpp4<0x121>(acc[ai][bj][m - 1][n]); r2p = dpp4<0x122>(acc[ai][bj][m - 1][n]); }
                        else { const f32x4 hm2 = *(const PG8_LAS f32x4*)(xl + (srcc * 2 + 0) * 256 + lc) * hz, hm1 = *(const PG8_LAS f32x4*)(xl + (srcc * 2 + 1) * 256 + lc) * hz; r1p = hm1; r2p = (fr == 0) ? hm2 : hm1; }
                        const f32x4 r1c = dpp4<0x121>(cur), r2c = dpp4<0x122>(cur);
                        acc[ai][bj][m][n] = bb + w2 * cur + w1a * r1c + w1b * r1p + w0a * r2c + w0b * r2p;
                    }
                }
                EPI_FENCE();
            }
        EPI_ROWS(ai, m) {
            const int row = row0 + ai * HALF + m * 16;
            f32x4 g0 = acc[ai][0][m][0], g1 = acc[ai][0][m][1];
#pragma unroll
            for (int h = 0; h < 2; ++h) {
                const f32x2 a0 = gelu_t2((f32x2){g0[2 * h], g0[2 * h + 1]}) * (f32x2){acc[ai][1][m][0][2 * h], acc[ai][1][m][0][2 * h + 1]};
                const f32x2 a1 = gelu_t2((f32x2){g1[2 * h], g1[2 * h + 1]}) * (f32x2){acc[ai][1][m][1][2 * h], acc[ai][1][m][1][2 * h + 1]};
                g0[2 * h] = a0[0]; g0[2 * h + 1] = a0[1]; g1[2 * h] = a1[0]; g1[2 * h + 1] = a1[1]; }
            *(GAS u32x4*)(mo + (size_t)row * FF + u.pn * HALF + jc) = pack8(g0, g1);
        }
    }
};
struct EpiNull {
    static constexpr bool PERM = true, AFTER_DRAIN = false;
    typedef NoPre Pre; __device__ __forceinline__ void prefetch(Pre&, const Unit&, int, int, int, int) const {}
    __device__ __forceinline__ void operator()(f32x4 (&acc)[2][2][4][2], const Unit& u, int wr, int wc, int fr, int fq, const Pre&) const {
        EPI_ROWS(ai, m) { asm volatile("" :: "v"(acc[ai][0][m][0]), "v"(acc[ai][0][m][1]), "v"(acc[ai][1][m][0]), "v"(acc[ai][1][m][1])); }
    }
};
#undef EPI_ROWS

template <class Epi, class Sched, bool ALIGN_EPI = false, bool SP2 = false>
__device__ __forceinline__ void gemm_phase(PG8_LAS unsigned char* lds, const Gemm g, const Sched& S, const Epi& E, int wave_id) {
    int tid_ = wave_id * 64 + lane_id_now();
    const int tid = tid_, wid = __builtin_amdgcn_readfirstlane(tid >> 6), lane = tid & 63, wr = wid >> 2, wc = wid & 3, fr = lane & 15, fq = lane >> 4;
    const int K = g.K, nt = K / BK;
    unsigned voffA[2], voffB[2];
#pragma unroll
    for (int i = 0; i < 2; ++i) { int R, C; stage_rc(tid * 16 + i * 8192, R, C); const int Rb = Epi::PERM ? ((R & ~31) + perm32(R & 31)) : R;
        voffA[i] = (unsigned)(R * K + C) * 2u; voffB[i] = (unsigned)(Rb * K + C) * 2u; }
    const size_t kstep = (size_t)(BK * 2);
    const size_t hstep = (size_t)HALF * K * 2;
    const size_t tstep = 2 * hstep;
    const unsigned ldsw = (unsigned)wid * 1024u;
    const int aoff = lds_byte(wr * 64 + fr, fq * 8), boff = lds_byte(wc * 32 + fr, fq * 8);
#define PG8_SA(b, h) (((b) * 2 + (h)) * HTB)
#define PG8_SB(b, h) ((4 + (b) * 2 + (h)) * HTB)
#define PG8_STAGE(bufoff, gbase, voff) do { _Pragma("unroll") for (int _i = 0; _i < 2; ++_i) \
        __builtin_amdgcn_global_load_lds((const unsigned*)((const char*)(gbase) + (voff)[_i]), (PG8_LAS unsigned*)(lds + (bufoff) + ldsw + _i * 8192), 16, 0, 0); } while (0)
#define PG8_LDA(dst, b, h) do { _Pragma("unroll") for (int m = 0; m < 4; ++m) _Pragma("unroll") for (int k = 0; k < 2; ++k) dst[m][k] = *(const PG8_LAS bf16x8*)(lds + PG8_SA(b, h) + aoff + m * 2048 + k * 1024); } while (0)
#define PG8_LDB(dst, b, h) do { _Pragma("unroll") for (int n = 0; n < 2; ++n) _Pragma("unroll") for (int k = 0; k < 2; ++k) dst[n][k] = *(const PG8_LAS bf16x8*)(lds + PG8_SB(b, h) + boff + n * 2048 + k * 1024); } while (0)
#define PG8_MMA(ai, bj, At, Bt) do { __builtin_amdgcn_s_setprio(1); _Pragma("unroll") for (int m = 0; m < 4; ++m) _Pragma("unroll") for (int n = 0; n < 2; ++n) _Pragma("unroll") for (int k = 0; k < 2; ++k) \
        acc[ai][bj][m][n] = __builtin_amdgcn_mfma_f32_16x16x32_bf16(Bt[n][k], At[m][k], acc[ai][bj][m][n], 0, 0, 0); __builtin_amdgcn_s_setprio(0); } while (0)
#define PG8_WAIT_V(n) asm volatile("s_waitcnt vmcnt(" #n ")" ::: "memory")
#define PG8_WAIT_L(n) asm volatile("s_waitcnt lgkmcnt(" #n ")" ::: "memory")
#define PG8_BAR __builtin_amdgcn_s_barrier()
#define PG8_SCHED __builtin_amdgcn_sched_barrier(0)
    Unit cur, nxt; int ui = 0; typename Epi::Pre pre;
    if (!S.next(0, cur)) return;
    f32x4 acc[2][2][4][2];
#pragma unroll
    for (int a = 0; a < 2; ++a)
#pragma unroll
        for (int b = 0; b < 2; ++b)
#pragma unroll
            for (int m = 0; m < 4; ++m)
#pragma unroll
                for (int n = 0; n < 2; ++n) acc[a][b][m][n] = (f32x4){0.f, 0.f, 0.f, 0.f};
    bf16x8 At[4][2], B0[2][2], B1[2][2];
    const char* cA = (const char*)g.A + (size_t)cur.pm * tstep; const char* cB = (const char*)g.Bt + (size_t)cur.pn * tstep;
    S.a_ready(cur);
    if constexpr (SP2) {
        PG8_STAGE(PG8_SB(0, 0), cB, voffB); PG8_STAGE(PG8_SB(0, 1), cB + hstep, voffB); PG8_STAGE(PG8_SA(0, 0), cA, voffA); PG8_STAGE(PG8_SA(0, 1), cA + hstep, voffA);
        if (wr == 1) PG8_BAR;
        PG8_WAIT_V(2); PG8_BAR;
        PG8_STAGE(PG8_SB(1, 0), cB + kstep, voffB); PG8_STAGE(PG8_SA(1, 0), cA + kstep, voffA); PG8_STAGE(PG8_SB(1, 1), cB + hstep + kstep, voffB);
        PG8_WAIT_V(6); PG8_BAR;
    } else {
        PG8_STAGE(PG8_SB(0, 0), cB, voffB); PG8_STAGE(PG8_SA(0, 0), cA, voffA); PG8_STAGE(PG8_SB(0, 1), cB + hstep, voffB); PG8_STAGE(PG8_SA(0, 1), cA + hstep, voffA);
        if (wr == 1) PG8_BAR;
        PG8_WAIT_V(4); PG8_BAR;
        PG8_STAGE(PG8_SB(1, 0), cB + kstep, voffB); PG8_STAGE(PG8_SA(1, 0), cA + kstep, voffA); PG8_STAGE(PG8_SB(1, 1), cB + hstep + kstep, voffB);
        PG8_WAIT_V(6); PG8_BAR;
    }
    for (;;) {
        const bool has_next = S.next(ui + 1, nxt);
        const char* nA = has_next ? (const char*)g.A + (size_t)nxt.pm * tstep : cA; const char* nB = has_next ? (const char*)g.Bt + (size_t)nxt.pn * tstep : cB;
#pragma unroll 1
        for (int t = 0; t < nt; t += 2) {
            const bool last = (t == nt - 2);
            const char* a1 = cA + (size_t)(t + 1) * kstep;
            const char* a2 = last ? nA : cA + (size_t)(t + 2) * kstep; const char* b2 = last ? nB : cB + (size_t)(t + 2) * kstep;
            const char* a3 = a2 + kstep; const char* b3 = b2 + kstep;
            if (last && has_next) S.a_ready(nxt);
            if (last) E.prefetch(pre, cur, wr, wc, fr, fq);
            if constexpr (SP2) {
            PG8_LDB(B0, 0, 0); PG8_LDB(B1, 0, 1); PG8_SCHED; PG8_LDA(At, 0, 0); PG8_STAGE(PG8_SA(1, 1), a1 + hstep, voffA);
            PG8_WAIT_V(8); PG8_WAIT_L(0); PG8_BAR; PG8_MMA(0, 0, At, B0); PG8_MMA(0, 1, At, B1); PG8_BAR; PG8_SCHED;
            PG8_LDA(At, 0, 1); PG8_STAGE(PG8_SB(0, 0), b2, voffB); PG8_STAGE(PG8_SB(0, 1), b2 + hstep, voffB); PG8_STAGE(PG8_SA(0, 0), a2, voffA);
            PG8_WAIT_V(8); PG8_WAIT_L(0); PG8_BAR; PG8_MMA(1, 0, At, B0); PG8_MMA(1, 1, At, B1); PG8_BAR; PG8_SCHED;
            PG8_LDB(B0, 1, 0); PG8_LDB(B1, 1, 1); PG8_SCHED; PG8_LDA(At, 1, 0); PG8_STAGE(PG8_SA(0, 1), a2 + hstep, voffA);
            PG8_WAIT_V(8); PG8_WAIT_L(0); PG8_BAR; PG8_MMA(0, 0, At, B0); PG8_MMA(0, 1, At, B1); PG8_BAR; PG8_SCHED;
            PG8_LDA(At, 1, 1); PG8_STAGE(PG8_SB(1, 0), b3, voffB); PG8_STAGE(PG8_SB(1, 1), b3 + hstep, voffB); PG8_STAGE(PG8_SA(1, 0), a3, voffA);
            PG8_WAIT_V(8); PG8_WAIT_L(0); PG8_BAR; PG8_MMA(1, 0, At, B0); PG8_MMA(1, 1, At, B1); PG8_BAR; PG8_SCHED;
            } else {
            PG8_LDB(B0, 0, 0); PG8_SCHED; PG8_LDA(At, 0, 0); PG8_STAGE(PG8_SA(1, 1), a1 + hstep, voffA);
            PG8_WAIT_L(8); PG8_BAR; PG8_WAIT_L(0); PG8_MMA(0, 0, At, B0); PG8_BAR; PG8_SCHED;
            PG8_LDB(B1, 0, 1); PG8_STAGE(PG8_SB(0, 0), b2, voffB);
            PG8_BAR; PG8_WAIT_L(0); PG8_MMA(0, 1, At, B1); PG8_BAR;
            PG8_LDA(At, 0, 1); PG8_STAGE(PG8_SA(0, 0), a2, voffA);
            PG8_BAR; PG8_WAIT_L(0); PG8_MMA(1, 0, At, B0); PG8_BAR; PG8_SCHED;
            PG8_STAGE(PG8_SB(0, 1), b2 + hstep, voffB);
            PG8_WAIT_V(6); PG8_BAR; PG8_MMA(1, 1, At, B1); PG8_BAR;
            PG8_LDB(B0, 1, 0); PG8_SCHED; PG8_LDA(At, 1, 0); PG8_STAGE(PG8_SA(0, 1), a2 + hstep, voffA);
            PG8_WAIT_L(8); PG8_BAR; PG8_WAIT_L(0); PG8_MMA(0, 0, At, B0); PG8_BAR; PG8_SCHED;
            PG8_LDB(B1, 1, 1); PG8_STAGE(PG8_SB(1, 0), b3, voffB);
            PG8_BAR; PG8_WAIT_L(0); PG8_MMA(0, 1, At, B1); PG8_BAR;
            PG8_LDA(At, 1, 1); PG8_STAGE(PG8_SA(1, 0), a3, voffA);
            PG8_BAR; PG8_WAIT_L(0); PG8_MMA(1, 0, At, B0); PG8_BAR; PG8_SCHED;
            PG8_STAGE(PG8_SB(1, 1), b3 + hstep, voffB);
            PG8_WAIT_V(6); PG8_BAR; PG8_MMA(1, 1, At, B1); PG8_BAR;
            }
        }
        if constexpr (ALIGN_EPI) { if (wr == 0) PG8_BAR; }
        if constexpr (!Epi::AFTER_DRAIN) { E(acc, cur, wr, wc, fr, fq, pre); S.done(cur); }
        if (!has_next) break;
#pragma unroll
        for (int a = 0; a < 2; ++a)
#pragma unroll
            for (int b = 0; b < 2; ++b)
#pragma unroll
                for (int m = 0; m < 4; ++m)
#pragma unroll
                    for (int n = 0; n < 2; ++n) acc[a][b][m][n] = (f32x4){0.f, 0.f, 0.f, 0.f};
        cur = nxt; cA = nA; cB = nB; ++ui;
        if constexpr (ALIGN_EPI) { if (wr == 1) PG8_BAR; }
    }
    PG8_WAIT_V(0);
    if constexpr (!ALIGN_EPI) { if (wr == 0) PG8_BAR; }
    PG8_BAR;
    if constexpr (Epi::AFTER_DRAIN) { E.fused(acc, cur, wr, wc, fr, fq, lds, wid, lane); S.done(cur); }
#undef PG8_SA
#undef PG8_SB
#undef PG8_STAGE
#undef PG8_LDA
#undef PG8_LDB
#undef PG8_MMA
#undef PG8_WAIT_V
#undef PG8_WAIT_L
#undef PG8_BAR
#undef PG8_SCHED
}
}

#define XB_TMO      128
#define XB_XCNT(j)  (256  + 64 * (j))
#define XB_XSUB(j)  (1280 + 64 * (j))
#define XB_XGEN(j)  (2304 + 64 * (j))
#define XB_TOP      3328
#define XB_TOPGEN   3392
#define XB_LSUB(j)  (3456 + 64 * (j))
#define XB_LGEN(j)  (4480 + 64 * (j))
#define XB_EV(i)    (5504 + 64 * (i))
#define XCD_BAR_WORDS 6528
#define XB_SPIN_CAP (1u << 18)

__device__ __forceinline__ unsigned xb_ld(unsigned* p)              { return __hip_atomic_load(p, __ATOMIC_RELAXED, __HIP_MEMORY_SCOPE_AGENT); }
__device__ __forceinline__ unsigned xb_add(unsigned* p, unsigned v) { return __hip_atomic_fetch_add(p, v, __ATOMIC_RELAXED, __HIP_MEMORY_SCOPE_AGENT); }
__device__ __forceinline__ unsigned xb_xcc_id() { return (unsigned)__builtin_amdgcn_s_getreg((3 << 11) | 20) & 0xFu; }
#define XB_SPIN(cond, bar) do { unsigned _sp = 0; while (cond) { __builtin_amdgcn_s_sleep(1); \
    if ((++_sp & 255u) == 0u) { if (xb_ld(&(bar)[XB_TMO])) break; if (_sp > XB_SPIN_CAP) { atomicAdd(&(bar)[XB_TMO], 1u); break; } } } } while (0)

struct XcdBarrier {
    unsigned* bar; unsigned x;
    volatile LAS unsigned* st;
};

__device__ __forceinline__ XcdBarrier xcd_barrier_post(unsigned* bar, volatile LAS unsigned* st) {
    XcdBarrier b; b.bar = bar; b.x = xb_xcc_id(); b.st = st;
    if (threadIdx.x == 0) st[2] = xb_add(&bar[XB_XCNT(b.x)], 1u);
    return b;
}
__device__ __forceinline__ void xcd_barrier_complete(unsigned* bar, unsigned x, unsigned& nloc, unsigned& nx, unsigned& even8) {
    const unsigned G = gridDim.x * gridDim.y * gridDim.z;
    unsigned sum, cnt, mine, bad, sp = 0u;
    for (;;) {
        sum = 0u; cnt = 0u; mine = 0u; bad = 0u;
#pragma unroll
        for (unsigned j = 0; j < 16; ++j) { const unsigned c = xb_ld(&bar[XB_XCNT(j)]); sum += c; cnt += (c > 0u) ? 1u : 0u; mine = (j == x) ? c : mine; bad |= (j < 8u) ? (c * 8u != G) : (c != 0u); }
        if (sum == G) break;
        __builtin_amdgcn_s_sleep(1);
        if ((++sp & 255u) == 0u) { if (xb_ld(&bar[XB_TMO])) break; if (sp > XB_SPIN_CAP) { atomicAdd(&bar[XB_TMO], 1u); break; } }
    }
    nloc = mine > 0u ? mine : 1u; nx = cnt > 0u ? cnt : 1u;
    even8 = (sum == G && bad == 0u) ? 1u : 0u;
}

__device__ __forceinline__ void xcd_barrier(const XcdBarrier& b) {
    asm volatile("s_waitcnt vmcnt(0)" ::: "memory");
    __syncthreads();
    if (threadIdx.x == 0) {
        unsigned* bar = b.bar;
        __builtin_amdgcn_s_waitcnt(0);
        unsigned nloc = b.st[0], nx = b.st[1];
        if (nloc == 0u) { unsigned e8; xcd_barrier_complete(bar, b.x, nloc, nx, e8); b.st[0] = nloc; b.st[1] = nx; b.st[3] = e8; }
        const unsigned old = xb_add(&bar[XB_XSUB(b.x)], 1u);
        const unsigned gen = old / nloc;
        if (old + 1u == (gen + 1u) * nloc) {
            __builtin_amdgcn_fence(__ATOMIC_RELEASE, "agent");
            asm volatile("s_waitcnt vmcnt(0)" ::: "memory");
            const unsigned og = xb_add(&bar[XB_TOP], 1u);
            const unsigned tg = og / nx;
            if (og + 1u == (tg + 1u) * nx) xb_add(&bar[XB_TOPGEN], 1u);
            else XB_SPIN(xb_ld(&bar[XB_TOPGEN]) == tg, bar);
            __builtin_amdgcn_fence(__ATOMIC_ACQUIRE, "agent");
            xb_add(&bar[XB_XGEN(b.x)], 1u);
            asm volatile("s_waitcnt vmcnt(0)" ::: "memory");
        } else {
            XB_SPIN(xb_ld(&bar[XB_XGEN(b.x)]) == gen, bar);
            __builtin_amdgcn_fence(__ATOMIC_ACQUIRE, "agent");
            asm volatile("s_waitcnt vmcnt(0)" ::: "memory");
        }
    }
    __syncthreads();
}

__device__ __forceinline__ void xcd_local_barrier(const XcdBarrier& b, int sig1 = -1, int sig2 = -1, bool rel = false) {
    asm volatile("s_waitcnt vmcnt(0)" ::: "memory");
    __syncthreads();
    if (threadIdx.x == 0) {
        unsigned* bar = b.bar;
        __builtin_amdgcn_s_waitcnt(0);
        const unsigned nloc = b.st[0];
        const unsigned old = xb_add(&bar[XB_LSUB(b.x)], 1u);
        const unsigned gen = old / nloc;
        if (old + 1u == (gen + 1u) * nloc) {
            if (rel) { __builtin_amdgcn_fence(__ATOMIC_RELEASE, "agent"); asm volatile("s_waitcnt vmcnt(0)" ::: "memory"); }
            if (sig1 >= 0) xb_add(&bar[XB_EV(sig1)], 1u);
            if (sig2 >= 0) xb_add(&bar[XB_EV(sig2)], 1u);
            xb_add(&bar[XB_LGEN(b.x)], 1u);
        } else XB_SPIN(xb_ld(&bar[XB_LGEN(b.x)]) == gen, bar);
        __builtin_amdgcn_fence(__ATOMIC_ACQUIRE, "agent");
        asm volatile("s_waitcnt vmcnt(0)" ::: "memory");
    }
    __syncthreads();
}

__device__ __forceinline__ void xcd_event_wait(const XcdBarrier& b, int ev, unsigned target, bool acq) {
    if (threadIdx.x == 0) {
        unsigned* bar = b.bar;
        XB_SPIN(xb_ld(&bar[XB_EV(ev)]) < target, bar);
        if (acq) { __builtin_amdgcn_fence(__ATOMIC_ACQUIRE, "agent"); asm volatile("s_waitcnt vmcnt(0)" ::: "memory"); }
    }
    __syncthreads();
}

struct Ctx { LAS unsigned char* lds; int tid, lane, wave, G, bid; };
__device__ __forceinline__ Ctx fresh(const Ctx& C) { Ctx R = C; const int t = C.wave * 64 + lane_id_now(); R.tid = t; R.lane = t & 63; return R; }
__device__ __forceinline__ int grp_of(const Ctx& C) { return C.bid & 7; }
__device__ __forceinline__ int rank_of(const Ctx& C) { return C.bid >> 3; }
__device__ __forceinline__ int nper_of(const Ctx& C) { return C.G >> 3; }
__device__ __forceinline__ unsigned char* actp(unsigned char* ws, const Ctx& C, size_t off, size_t shift) { return ws + WS_ACT + off / 8 + (size_t)(C.bid & 7) * (SLAB - shift); }
#define ACT_TM(ws, C, OFF, W) actp((ws), (C), (OFF), (size_t)4096 * (W) * 2)
#define ACT_VT(ws, C) actp((ws), (C), A_VT, (size_t)4096 * 2)

enum MapKind { MK_ID = 0, MK_EIN, MK_QUP, MK_KVK, MK_KVV, MK_FUP };
__device__ __forceinline__ int map_col(int kind, int rho0) {
    switch (kind) {
    case MK_EIN: { if (rho0 < 768) return rho0; if (rho0 < 2816) return rho0 + 64; const int q = rho0 - 2816, bj = q >> 7, jj = q & 127; return jj < 32 ? 768 + 32 * bj + jj : -1; }
    case MK_QUP: { const int pn = rho0 >> 8, q = rho0 & 255, bj = q >> 7, jj = q & 127; if (pn < 4) return (2 * pn + bj) * QKD + jj; return (4 * (pn - 4) + (jj >> 5)) * QKD + 128 + 32 * bj; }
    case MK_KVK: return (rho0 >> 7) * 256 + (rho0 & 127);
    case MK_KVV: return (rho0 >> 7) * 256 + 128 + (rho0 & 127);
    case MK_FUP: { const int pn = rho0 >> 8, q = rho0 & 255; return (q >> 7) * FF + pn * 128 + (q & 127); }
    default: return rho0;
    }
}
__device__ __forceinline__ void tr_item(const float* W, int Nsrc, int K, const float* gain, int kind, bf16_t* WT, int nblk, int item, LAS float* scr, int lane) {
    const int kb = item / nblk, nb = item % nblk, k0 = 64 * kb, rho0 = 32 * nb, sc0 = map_col(kind, rho0);
    if (sc0 >= 0) {
        float v[32];
        const GAS float* wp = (const GAS float*)(W + (size_t)(k0 + (lane >> 5)) * Nsrc + sc0 + (lane & 31));
#pragma unroll
        for (int i = 0; i < 32; ++i) v[i] = __builtin_nontemporal_load(wp + (size_t)(2 * i) * Nsrc);
        if (gain) { const GAS float* gp = (const GAS float*)(gain + k0 + (lane >> 5));
#pragma unroll
            for (int i = 0; i < 32; ++i) v[i] *= gp[2 * i]; }
#pragma unroll
        for (int i = 0; i < 32; ++i) scr[(2 * i + (lane >> 5)) * 33 + (lane & 31)] = v[i];
    } else {
#pragma unroll 8
        for (int i = 0; i < 32; ++i) { const int kk = 2 * i + (lane >> 5); scr[kk * 33 + (lane & 31)] = 0.f; }
    }
    LDS_WAIT();
    const int c = lane & 7;
#pragma unroll
    for (int j = 0; j < 4; ++j) { const int n = (lane >> 3) + 8 * j; const LAS float* s = scr + (8 * c) * 33 + n;
        u32x4 o; o.x = pk2(s[0 * 33], s[1 * 33]); o.y = pk2(s[2 * 33], s[3 * 33]); o.z = pk2(s[4 * 33], s[5 * 33]); o.w = pk2(s[6 * 33], s[7 * 33]);
        *(GAS u32x4*)(WT + (size_t)(rho0 + n) * K + k0 + 8 * c) = o; }
    LDS_WAIT();
}
__device__ __forceinline__ void tr_job(const Ctx& C, const float* W, const float* gain, bf16_t* WT, int Nsrc, int K, int Nout, int kind, int& base, unsigned* ctr) {
    LAS float* scr = (LAS float*)(C.lds + C.wave * 16384);
    const int nblk = Nout / 32, nit = (K / 64) * nblk;
    if (ctr) {
        volatile LAS unsigned* slot = (volatile LAS unsigned*)(C.lds + LDS_MISC + 64);
        for (;;) {
            if (C.tid == 0) *slot = __hip_atomic_fetch_add(ctr, 32u, __ATOMIC_RELAXED, __HIP_MEMORY_SCOPE_AGENT);
            __syncthreads();
            const int b = (int)*slot;
            __syncthreads();
            if (b >= nit) break;
#pragma unroll 1
            for (int q = 0; q < 4; ++q) { const int it = b + q * 8 + C.wave; if (it < nit) tr_item(W, Nsrc, K, gain, kind, WT, nblk, it, scr, C.lane); }
        }
    } else {
        const int gw = C.bid * 8 + C.wave, NGW = C.G * 8;
        int it = gw - (base % NGW); if (it < 0) it += NGW;
        for (; it < nit; it += NGW) tr_item(W, Nsrc, K, gain, kind, WT, nblk, it, scr, C.lane);
        base += nit;
    }
}
__device__ __forceinline__ void cvt_rows(const Ctx& C, const float* src, bf16_t* dst, size_t n) {
    const size_t stride = (size_t)C.G * 512 * 8;
    for (size_t i = ((size_t)C.bid * 512 + C.tid) * 8; i < n; i += stride) { const f32x4 a = *(const GAS f32x4*)(src + i), b = *(const GAS f32x4*)(src + i + 4); *(GAS u32x4*)(dst + i) = pack8(a, b); }
}

__device__ __forceinline__ void phase_init(const Ctx& C0, const float* x, const int* pos, float* tabm, float* tabr, bf16_t* hb, float* psh) {
    const Ctx C = fresh(C0);
    const size_t gt = (size_t)C.bid * 512 + C.tid, NT = (size_t)C.G * 512;
    for (size_t i = gt; i < (size_t)T * 32; i += NT) { const int t = (int)(i >> 5), j = (int)(i & 31); const float inv = powf(10000.0f, -(float)j / 32.0f), ang = (float)*(const GAS int*)(pos + t) * inv; float sn, cs; sincosf(ang, &sn, &cs); *(GAS f32x2*)(tabm + i * 2) = (f32x2){cs, sn}; }
    for (size_t i = gt; i < (size_t)T * 128; i += NT) { const int t = (int)(i >> 7), j = (int)(i & 127); const float inv = powf(10000.0f, -(float)j / 128.0f), ang = (float)*(const GAS int*)(pos + t) * inv; float sn, cs; sincosf(ang, &sn, &cs); const f16v2 hv = {(_Float16)cs, (_Float16)sn}; *(GAS unsigned*)((unsigned*)tabr + i) = __builtin_bit_cast(unsigned, hv); }
    const int gw = C.bid * 8 + C.wave, NGW = C.G * 8;
    for (int row = gw; row < T; row += NGW) {
        const float* xr = x + (size_t)row * D; float ss = 0.f;
#pragma unroll
        for (int j = 0; j < 4; ++j) { const int c = j * 512 + C.lane * 8; const f32x4 a = *(const GAS f32x4*)(xr + c), b = *(const GAS f32x4*)(xr + c + 4); *(GAS u32x4*)(hb + (size_t)row * D + c) = pack8(a, b); ss += dot4(a) + dot4(b); }
        ss = wave_sum(ss);
        if (C.lane < 8) *(GAS float*)(psh + (size_t)row * 8 + C.lane) = C.lane == 0 ? ss : 0.f;
    }
}

enum { PREP_MIX = 1, PREP_FUP = 2, PREP_PLEU = 4, PREP_FDN = 8, PREP_PLEG = 16, PREP_ALL = 31 };
__device__ __forceinline__ void phase_prep(const Ctx& C0, const void* const* in, unsigned char* ws, int L, int mask, bool dyn) {
    const Ctx C = fresh(C0);
    const int j = L >> 1; int base = 0;
    unsigned* const cq = dyn ? (unsigned*)(ws + WS_CTL) + 1024 + L * 16 : nullptr;
#define CQ(i) (dyn ? cq + (i) : nullptr)
    const float* mixg = (const float*)(const GAS float*)in[3] + (size_t)L * D;
    if (mask & PREP_MIX) {
    if ((L & 1) == 0) {
        tr_job(C, (const float*)(const GAS float*)in[4] + (size_t)j * D * EIN, mixg, (bf16_t*)(ws + WS_WMIX + WM_EIN), EIN, D, EINP, MK_EIN, base, CQ(0));
        tr_job(C, (const float*)(const GAS float*)in[6] + (size_t)j * QL * QUPN, (const float*)(const GAS float*)in[5] + (size_t)j * QL, (bf16_t*)(ws + WS_WMIX + WM_QUP), QUPN, QL, QUPN, MK_QUP, base, CQ(1));
        tr_job(C, (const float*)(const GAS float*)in[8] + (size_t)j * KVL * 2048, (const float*)(const GAS float*)in[7] + (size_t)j * KVL, (bf16_t*)(ws + WS_WMIX + WM_KVK), 2048, KVL, 1024, MK_KVK, base, CQ(2));
        tr_job(C, (const float*)(const GAS float*)in[8] + (size_t)j * KVL * 2048, (const float*)(const GAS float*)in[7] + (size_t)j * KVL, (bf16_t*)(ws + WS_WMIX + WM_KVV), 2048, KVL, 1024, MK_KVV, base, CQ(3));
        tr_job(C, (const float*)(const GAS float*)in[13] + (size_t)j * D * D, nullptr, (bf16_t*)(ws + WS_WMIX + WM_EOUT), D, D, D, MK_ID, base, CQ(4));
    } else {
        tr_job(C, (const float*)(const GAS float*)in[14] + (size_t)j * D * RIN, mixg, (bf16_t*)(ws + WS_WMIX + WM_RIN), RIN, D, RIN, MK_ID, base, CQ(5));
        tr_job(C, (const float*)(const GAS float*)in[17] + (size_t)j * RV * D, nullptr, (bf16_t*)(ws + WS_WMIX + WM_ROUT), D, RV, D, MK_ID, base, CQ(6));
    }
    }
    if (mask & PREP_FUP) tr_job(C, (const float*)(const GAS float*)in[19] + (size_t)L * D * FF2, (const float*)(const GAS float*)in[18] + (size_t)L * D, (bf16_t*)(ws + WS_WFFN + WF_UP), FF2, D, FF2, MK_FUP, base, CQ(7));
    if (mask & PREP_FDN) tr_job(C, (const float*)(const GAS float*)in[22] + (size_t)L * FF * D, nullptr, (bf16_t*)(ws + WS_WFFN + WF_DN), D, FF, D, MK_ID, base, CQ(8));
    if (mask & PREP_PLEG) tr_job(C, (const float*)(const GAS float*)in[24] + (size_t)L * D * D, (const float*)(const GAS float*)in[23] + (size_t)L * D, (bf16_t*)(ws + WS_WPLE + WP_G), D, D, D, MK_ID, base, CQ(9));
    if (mask & PREP_PLEU) tr_job(C, (const float*)(const GAS float*)in[25] + (size_t)L * PLE * D, nullptr, (bf16_t*)(ws + WS_WPLE + WP_U), D, PLE, D, MK_ID, base, CQ(10));
    if (mask & PREP_PLEU) cvt_rows(C, (const float*)(const GAS float*)in[1] + (size_t)L * T * PLE, (bf16_t*)(ws + WS_PBF), (size_t)T * PLE);
    if ((mask & PREP_MIX) && (L & 1) == 0) {
        const float* wsrc = (const float*)(const GAS float*)in[11] + (size_t)j * 8 * 128 * 128; bf16_t* wm = (bf16_t*)(ws + WS_WMIX + WM_WS);
        for (int i = C.bid * 512 + C.tid; i < 8 * 128 * 128; i += C.G * 512) { const int p = (i >> 7) & 127, q = i & 127; *(GAS bf16_t*)(wm + i) = (bf16_t)f2bf(((p >> 6) >= (q >> 6)) ? *(const GAS float*)(wsrc + i) : 0.f); }
    }
#undef CQ
    __syncthreads();
}

#define MFMA32(a, b, c) __builtin_amdgcn_mfma_f32_32x32x16_bf16((a), (b), (c), 0, 0, 0)
#define MFMA16(a, b, c) __builtin_amdgcn_mfma_f32_16x16x32_bf16((a), (b), (c), 0, 0, 0)
constexpr int AT_KST = 200, AT_VST = 72;
constexpr int AT_KB = 64 * AT_KST * 2, AT_VB = 128 * AT_VST * 2, AT_BUF = AT_KB + AT_VB;
__device__ __forceinline__ int swap23(int r) { return (r & ~12) | ((r & 4) << 1) | ((r & 8) >> 1); }
__device__ __forceinline__ bf16x8 pack_frag(const f32x16& x, int s) {
    u32x4 p; p.x = pk2(x[8 * s + 0], x[8 * s + 1]); p.y = pk2(x[8 * s + 2], x[8 * s + 3]); p.z = pk2(x[8 * s + 4], x[8 * s + 5]); p.w = pk2(x[8 * s + 6], x[8 * s + 7]);
    return __builtin_bit_cast(bf16x8, p);
}

__device__ __forceinline__ void attn_qk(const LAS bf16_t* ks, int r, int hh, const bf16x8 (&qf)[12], f32x16 (&st)[2]) {
#pragma unroll
    for (int kb = 0; kb < 2; ++kb) {
#pragma unroll
        for (int j = 0; j < 16; ++j) st[kb][j] = 0.f;
        const LAS bf16_t* kp = ks + (32 * kb + r) * AT_KST + 8 * hh;
        bf16x8 a0 = *(const LAS bf16x8*)(kp), a1 = *(const LAS bf16x8*)(kp + 16);
#pragma unroll
        for (int s = 0; s < 12; s += 2) {
            st[kb] = MFMA32(a0, qf[s], st[kb]); if (s + 2 < 12) a0 = *(const LAS bf16x8*)(kp + 16 * (s + 2));
            st[kb] = MFMA32(a1, qf[s + 1], st[kb]); if (s + 3 < 12) a1 = *(const LAS bf16x8*)(kp + 16 * (s + 3));
        }
    }
}
__device__ __forceinline__ void attn_sm(f32x16 (&st)[2], float& mrow, float& lrow, f32x16 (&o)[4], bf16x8 (&pf)[2][2]) {
    float mx = st[0][0];
#pragma unroll
    for (int j = 1; j < 16; ++j) mx = fmaxf(mx, st[0][j]);
#pragma unroll
    for (int j = 0; j < 16; ++j) mx = fmaxf(mx, st[1][j]);
    mx = fmaxf(mx, __shfl_xor(mx, 32));
    const float mn = fmaxf(mrow, mx), alpha = fexp2(mrow - mn);
    float rsum = 0.f;
#pragma unroll
    for (int kb = 0; kb < 2; ++kb)
#pragma unroll
        for (int j = 0; j < 16; ++j) { const float p = fexp2(st[kb][j] - mn); st[kb][j] = p; rsum += p; }
    rsum += __shfl_xor(rsum, 32);
    lrow = lrow * alpha + rsum; mrow = mn;
#pragma unroll
    for (int db = 0; db < 4; ++db) o[db] *= alpha;
#pragma unroll
    for (int kb = 0; kb < 2; ++kb)
#pragma unroll
        for (int s = 0; s < 2; ++s) pf[kb][s] = pack_frag(st[kb], s);
}
__device__ __forceinline__ void attn_pv(const LAS bf16_t* vs, int r, int hh, const bf16x8 (&pf)[2][2], f32x16 (&o)[4]) {
    const LAS bf16_t* vp = vs + r * AT_VST + 8 * hh;
    bf16x8 v0 = *(const LAS bf16x8*)(vp), v1 = *(const LAS bf16x8*)(vp + 16), v2 = *(const LAS bf16x8*)(vp + 32), v3 = *(const LAS bf16x8*)(vp + 48);
#pragma unroll
    for (int db = 0; db < 4; ++db) {
        o[db] = MFMA32(v0, pf[0][0], o[db]); if (db < 3) v0 = *(const LAS bf16x8*)(vp + 32 * (db + 1) * AT_VST);
        o[db] = MFMA32(v1, pf[0][1], o[db]); if (db < 3) v1 = *(const LAS bf16x8*)(vp + 32 * (db + 1) * AT_VST + 16);
        o[db] = MFMA32(v2, pf[1][0], o[db]); if (db < 3) v2 = *(const LAS bf16x8*)(vp + 32 * (db + 1) * AT_VST + 32);
        o[db] = MFMA32(v3, pf[1][1], o[db]); if (db < 3) v3 = *(const LAS bf16x8*)(vp + 32 * (db + 1) * AT_VST + 48);
    }
}
__device__ __forceinline__ void attn_unit(const Ctx& C, const bf16_t* Q, const bf16_t* Kn, const bf16_t* Kr, const bf16_t* Vt, bf16_t* ab, int b, int h, int qt) {
    const int lane = C.lane, w8 = C.wave, r = lane & 31, hh = lane >> 5, tid = C.tid;
    const bool late = w8 >= 4;
    const int tq = b * SEQ + qt * 256 + w8 * 32 + r;
    bf16x8 qf[12];
    { const bf16_t* qp = Q + ((size_t)tq * 8 + h) * QKD + 8 * hh;
#pragma unroll
      for (int ks = 0; ks < 12; ++ks) qf[ks] = *(const GAS bf16x8*)(qp + 16 * ks); }
    const int cwv = qt * 4 + (w8 >> 1), nt = qt * 4 + 4;
    f32x16 o[4];
#pragma unroll
    for (int i = 0; i < 4; ++i)
#pragma unroll
        for (int j = 0; j < 16; ++j) o[i][j] = 0.f;
    float mrow = -1e30f, lrow = 0.f;
    const int srow = tid >> 3, c8 = tid & 7;
    const size_t tk0 = (size_t)b * SEQ + swap23(srow);
    const bf16_t* kn0 = Kn + (tk0 * 8 + h) * 128 + c8 * 8; const bf16_t* kr0 = Kr + tk0 * 64 + c8 * 8;
    const bf16_t* vt0 = Vt + (size_t)(h * 128 + srow) * VTP + (size_t)b * SEQ + c8 * 8;
    const int kd0 = (srow * AT_KST + c8 * 8) * 2, vd0 = AT_KB + (srow * AT_VST + c8 * 8) * 2;
#define AT_LOAD(kt_) do { kreg[0] = *(const GAS u32x4*)(kn0 + (size_t)(kt_) * (64 * 1024)); kreg[1] = *(const GAS u32x4*)(kn0 + (size_t)(kt_) * (64 * 1024) + 64); kreg[2] = *(const GAS u32x4*)(kr0 + (size_t)(kt_) * (64 * 64)); \
        vreg[0] = *(const GAS u32x4*)(vt0 + (kt_) * 64); vreg[1] = *(const GAS u32x4*)(vt0 + (size_t)64 * VTP + (kt_) * 64); } while (0)
#define AT_WRITE(base_) do { LAS unsigned char* nb_ = (base_); *(LAS u32x4*)(nb_ + kd0) = kreg[0]; *(LAS u32x4*)(nb_ + kd0 + 128) = kreg[1]; *(LAS u32x4*)(nb_ + kd0 + 256) = kreg[2]; \
        *(LAS u32x4*)(nb_ + vd0) = vreg[0]; *(LAS u32x4*)(nb_ + vd0 + 64 * AT_VST * 2) = vreg[1]; } while (0)
    u32x4 kreg[3], vreg[2];
    AT_LOAD(0); AT_WRITE(C.lds);
    __syncthreads();
    if (late && nt > 1) AT_LOAD(1);
    int bc = 0;
    for (int kt = 0; kt < nt; ++kt) {
        const bool more = kt + 1 < nt;
        const int bn = bc == 2 ? 0 : bc + 1;
        if (!late && more) AT_LOAD(kt + 1);
        f32x16 st[2]; bf16x8 pf[2][2];
        const bool act = kt <= cwv;
        if (act) attn_qk((const LAS bf16_t*)(C.lds + bc * AT_BUF), r, hh, qf, st);
        if (late) {
            if (more) AT_WRITE(C.lds + bn * AT_BUF);
            if (kt + 2 < nt) AT_LOAD(kt + 2);
            __syncthreads();
        }
        if (act) {
            attn_sm(st, mrow, lrow, o, pf);
            attn_pv((const LAS bf16_t*)(C.lds + bc * AT_BUF + AT_KB), r, hh, pf, o);
        }
        if (!late) {
            if (more) AT_WRITE(C.lds + bn * AT_BUF);
            __syncthreads();
        }
        bc = bn;
    }
    const float inv = 1.0f / lrow;
    const int l2_ = lane_id_now();
    bf16_t* op = ab + (size_t)(b * SEQ + qt * 256 + w8 * 32 + (l2_ & 31)) * D + h * 128 + 4 * (l2_ >> 5);
#pragma unroll
    for (int db = 0; db < 4; ++db)
#pragma unroll
        for (int g = 0; g < 4; ++g) { u32x2 w; w.x = pk2(o[db][4 * g] * inv, o[db][4 * g + 1] * inv); w.y = pk2(o[db][4 * g + 2] * inv, o[db][4 * g + 3] * inv); *(GAS u32x2*)(op + 32 * db + 8 * g) = w; }
    __syncthreads();
#undef AT_LOAD
#undef AT_WRITE
}
__device__ __forceinline__ void phase_attn(const Ctx& C0, unsigned char* ws) {
    const Ctx C = fresh(C0);
    const bf16_t* Q = (const bf16_t*)ACT_TM(ws, C, A_Q, QUPN); const bf16_t* Kn = (const bf16_t*)ACT_TM(ws, C, A_KN, 1024); const bf16_t* Kr = (const bf16_t*)ACT_TM(ws, C, A_KROT, 64);
    const bf16_t* Vt = (const bf16_t*)ACT_VT(ws, C); bf16_t* ab = (bf16_t*)ACT_TM(ws, C, A_AB, D);
    for (int li = rank_of(C); li < 32; li += nper_of(C)) {
        const int slot = grp_of(C) * 32 + li;
        const int bh = slot >> 1, b = bh >> 3, h = bh & 7, odd = slot & 1;
#pragma unroll 1
        for (int i = 0; i < 4; ++i) {
            const int big = odd ? ((i & 2) ? 5 : 6) : ((i & 2) ? 4 : 7), qt = (i & 1) ? 7 - big : big;
            attn_unit(C, Q, Kn, Kr, Vt, ab, b, h, qt);
        }
    }
}

constexpr int SG_XST = 136;
constexpr int SG_STAT = 0, SG_XT = 1024, SG_SL = SG_XT + 128 * SG_XST * 2, SG_SST = 132;
__device__ __forceinline__ void sgu_unit(const Ctx& C, const bf16_t* ug, const bf16_t* vg, const float* psv, const bf16_t* wm, const float* lng, const float* lnb, const float* bs, bf16_t* ab, int blk, int g) {
    const int tid = C.tid, lane = C.lane, w8 = C.wave, r = lane & 31, hh = lane >> 5, t0 = blk * 128;
    LAS float* stat = (LAS float*)(C.lds + SG_STAT); LAS bf16_t* xt = (LAS bf16_t*)(C.lds + SG_XT); LAS float* sl = (LAS float*)(C.lds + SG_SL);
    if (tid < 128) {
        const GAS f32x4* p = (const GAS f32x4*)(psv + (size_t)(t0 + tid) * 32); float s1 = 0.f, s2 = 0.f;
#pragma unroll
        for (int i = 0; i < 8; ++i) { const f32x4 v = p[i]; s1 += v[0] + v[2]; s2 += v[1] + v[3]; }
        const float mu = s1 * (1.0f / 1024.0f), var = s2 * (1.0f / 1024.0f) - mu * mu;
        stat[tid * 2] = mu; stat[tid * 2 + 1] = rsqrtf(fmaxf(var, 0.f) + EPS);
    }
    __syncthreads();
    {
        const int tg = tid >> 4, cg = tid & 15, c0 = g * 128 + 8 * cg;
        const f32x4 ga = *(const GAS f32x4*)(lng + c0), gb = *(const GAS f32x4*)(lng + c0 + 4), ba = *(const GAS f32x4*)(lnb + c0), bb = *(const GAS f32x4*)(lnb + c0 + 4);
        float xn[4][8];
#pragma unroll
        for (int i = 0; i < 4; ++i) {
            const u32x4 w = *(const GAS u32x4*)(vg + (size_t)(t0 + 4 * tg + i) * 1024 + c0); const float mu = stat[(4 * tg + i) * 2], rsd = stat[(4 * tg + i) * 2 + 1];
            xn[i][0] = (bf_lo(w.x) - mu) * rsd * ga[0] + ba[0]; xn[i][1] = (bf_hi(w.x) - mu) * rsd * ga[1] + ba[1]; xn[i][2] = (bf_lo(w.y) - mu) * rsd * ga[2] + ba[2]; xn[i][3] = (bf_hi(w.y) - mu) * rsd * ga[3] + ba[3];
            xn[i][4] = (bf_lo(w.z) - mu) * rsd * gb[0] + bb[0]; xn[i][5] = (bf_hi(w.z) - mu) * rsd * gb[1] + bb[1]; xn[i][6] = (bf_lo(w.w) - mu) * rsd * gb[2] + bb[2]; xn[i][7] = (bf_hi(w.w) - mu) * rsd * gb[3] + bb[3];
        }
#pragma unroll
        for (int j = 0; j < 8; ++j) { u32x2 w; w.x = pk2(xn[0][j], xn[1][j]); w.y = pk2(xn[2][j], xn[3][j]); *(LAS u32x2*)(xt + (8 * cg + j) * SG_XST + 4 * tg) = w; }
    }
    __syncthreads();
    {
        const int pb = w8 >> 1, cb0 = 2 * (w8 & 1);
        f32x16 acc[2];
#pragma unroll
        for (int i = 0; i < 2; ++i)
#pragma unroll
            for (int j = 0; j < 16; ++j) acc[i][j] = 0.f;
        const bf16_t* wp = wm + ((size_t)g * 128 + 32 * pb + r) * 128 + 8 * hh;
#pragma unroll
        for (int s = 0; s < 8; ++s) {
            const bf16x8 a = *(const GAS bf16x8*)(wp + 16 * s);
#pragma unroll
            for (int i = 0; i < 2; ++i) { const bf16x8 bq = *(const LAS bf16x8*)(xt + (32 * (cb0 + i) + r) * SG_XST + 16 * s + 8 * hh); acc[i] = MFMA32(a, bq, acc[i]); }
        }
#pragma unroll
        for (int i = 0; i < 2; ++i)
#pragma unroll
            for (int j = 0; j < 16; ++j) { const int p = 32 * pb + (j & 3) + 8 * (j >> 2) + 4 * hh; sl[p * SG_SST + 32 * (cb0 + i) + r] = acc[i][j] + *(const GAS float*)(bs + g * 128 + p); }
    }
    __syncthreads();
#pragma unroll
    for (int i = 0; i < 4; ++i) {
        const int p = (tid >> 4) + 32 * i, cg = tid & 15; const size_t tok = (size_t)(t0 + p);
        const f32x4 sa = *(const LAS f32x4*)(sl + p * SG_SST + 8 * cg), sb = *(const LAS f32x4*)(sl + p * SG_SST + 8 * cg + 4);
        const u32x4 w = *(const GAS u32x4*)(ug + tok * 1024 + g * 128 + 8 * cg);
        f32x4 oa, ob; oa[0] = gelu_t(bf_lo(w.x)) * sa[0]; oa[1] = gelu_t(bf_hi(w.x)) * sa[1]; oa[2] = gelu_t(bf_lo(w.y)) * sa[2]; oa[3] = gelu_t(bf_hi(w.y)) * sa[3];
        ob[0] = gelu_t(bf_lo(w.z)) * sb[0]; ob[1] = gelu_t(bf_hi(w.z)) * sb[1]; ob[2] = gelu_t(bf_lo(w.w)) * sb[2]; ob[3] = gelu_t(bf_hi(w.w)) * sb[3];
        *(GAS u32x4*)(ab + tok * D + 1024 + g * 128 + 8 * cg) = pack8(oa, ob);
    }
    __syncthreads();
}
__device__ __forceinline__ void phase_sgu(const Ctx& C0, unsigned char* ws, const float* lng, const float* lnb, const float* bs) {
    const Ctx C = fresh(C0);
    const bf16_t* ug = (const bf16_t*)ACT_TM(ws, C, A_UG, 1024); const bf16_t* vg = (const bf16_t*)ACT_TM(ws, C, A_VG, 1024); const float* psv = (const float*)(ws + WS_PSV);
    const bf16_t* wm = (const bf16_t*)(ws + WS_WMIX + WM_WS); bf16_t* ab = (bf16_t*)ACT_TM(ws, C, A_AB, D);
#pragma unroll 1
    for (int li = rank_of(C); li < 256; li += nper_of(C)) { const int it = grp_of(C) * 256 + li; sgu_unit(C, ug, vg, psv, wm, lng, lnb, bs, ab, it >> 3, it & 7); }
}

constexpr int RT_QST = 264, RT_TST = 72;
constexpr int RT_QS = 0, RT_KS = 64 * RT_QST * 2, RT_KT = 2 * RT_KS, RT_VT = RT_KT + 256 * RT_TST * 2, RT_PS = RT_VT + 128 * RT_TST * 2, RT_END = RT_PS + 64 * RT_TST * 2;
static_assert(RT_END <= LDS_MISC, "retention LDS");
__device__ __forceinline__ void ret_unit(const Ctx& C, const bf16_t* rq, const bf16_t* rk, bf16_t* rv, int b, int h, int dvq, bool do_store) {
    const int tid = C.tid, lane = C.lane, w8 = C.wave, lr = lane & 15, lg = lane >> 4;
    LAS bf16_t* Qs = (LAS bf16_t*)(C.lds + RT_QS); LAS bf16_t* Ks = (LAS bf16_t*)(C.lds + RT_KS); LAS bf16_t* KT = (LAS bf16_t*)(C.lds + RT_KT);
    LAS bf16_t* VT = (LAS bf16_t*)(C.lds + RT_VT); LAS bf16_t* Ps = (LAS bf16_t*)(C.lds + RT_PS);
    const float lg2 = h == 0 ? -4.5803689613e-02f : h == 1 ? -2.2720076500e-02f : h == 2 ? -1.1315313228e-02f : h == 3 ? -5.6465631411e-03f : h == 4 ? -2.8205190624e-03f : h == 5 ? -1.4095702547e-03f : h == 6 ? -7.0461297659e-04f : -3.5226347163e-04f;
    const float g64 = h == 0 ? 1.3108403248e-01f : h == 1 ? 3.6498652424e-01f : h == 2 ? 6.0534099144e-01f : h == 3 ? 7.7841960936e-01f : h == 4 ? 8.8238904203e-01f : h == 5 ? 9.3938437596e-01f : h == 6 ? 9.6922583743e-01f : 9.8449455892e-01f;
    f32x4 st[16];
#pragma unroll
    for (int i = 0; i < 16; ++i) st[i] = (f32x4){0.f, 0.f, 0.f, 0.f};
    const int tg1 = tid >> 5, cg1 = tid & 31;
    const int tg2 = tid & 15, cg2 = tid >> 4;
    float kd[4];
#pragma unroll
    for (int i = 0; i < 4; ++i) kd[i] = fexp2(lg2 * (float)(63 - (4 * tg2 + i)));
    const size_t tb = (size_t)b * SEQ;
    const bf16_t* qsrc = rq + (tb + 4 * tg1) * 2048 + h * 256 + 8 * cg1;
    const bf16_t* ksrc = rk + (tb + 4 * tg1) * 2048 + h * 256 + 8 * cg1;
    bf16_t* vbase = rv + tb * RV + h * 512 + dvq * 128;
    const bf16_t* vsrc = vbase + (size_t)(4 * tg2) * RV + 4 * cg2;
    const int qdst = (4 * tg1) * RT_QST + 32 * (cg1 >> 2) + 16 * (cg1 & 1) + 4 * ((cg1 >> 1) & 1);
    const int kpat = (4 * tg2) * RT_QST + 32 * (cg2 >> 2) + 16 * (cg2 & 1) + 4 * ((cg2 >> 1) & 1);
    u32x4 qr[4], kr[4]; u32x2 vr[4];
#define RT_LOAD(n) do { _Pragma("unroll") for (int i = 0; i < 4; ++i) { qr[i] = *(const GAS u32x4*)(qsrc + ((size_t)(n) * 64 + i) * 2048); kr[i] = *(const GAS u32x4*)(ksrc + ((size_t)(n) * 64 + i) * 2048); \
        vr[i] = *(const GAS u32x2*)(vsrc + ((size_t)(n) * 64 + i) * RV); } } while (0)
#define RT_STAGE() do { \
        _Pragma("unroll") for (int i = 0; i < 4; ++i) { \
            *(LAS u32x2*)(Qs + qdst + i * RT_QST) = (u32x2){qr[i].x, qr[i].y}; *(LAS u32x2*)(Qs + qdst + i * RT_QST + 8) = (u32x2){qr[i].z, qr[i].w}; \
            *(LAS u32x2*)(Ks + qdst + i * RT_QST) = (u32x2){kr[i].x, kr[i].y}; *(LAS u32x2*)(Ks + qdst + i * RT_QST + 8) = (u32x2){kr[i].z, kr[i].w}; } \
        _Pragma("unroll") for (int w = 0; w < 2; ++w) { \
            u32x2 lo, hi; lo.x = (vr[0][w] & 0xffffu) | (vr[1][w] << 16); lo.y = (vr[2][w] & 0xffffu) | (vr[3][w] << 16); \
            hi.x = (vr[0][w] >> 16) | (vr[1][w] & 0xffff0000u); hi.y = (vr[2][w] >> 16) | (vr[3][w] & 0xffff0000u); \
            *(LAS u32x2*)(VT + (4 * cg2 + 2 * w) * RT_TST + 4 * tg2) = lo; *(LAS u32x2*)(VT + (4 * cg2 + 2 * w + 1) * RT_TST + 4 * tg2) = hi; } \
    } while (0)
    RT_LOAD(0);
    RT_STAGE();
    __syncthreads();
#pragma unroll 1
    for (int n = 0; n < 32; ++n) {
        const bool more = n + 1 < 32;
        if (more) RT_LOAD(n + 1);
        {
            u32x2 pl[4], ph[4];
#pragma unroll
            for (int i = 0; i < 4; ++i) { pl[i] = *(const LAS u32x2*)(Ks + kpat + i * RT_QST); ph[i] = *(const LAS u32x2*)(Ks + kpat + i * RT_QST + 8); }
#pragma unroll
            for (int w = 0; w < 4; ++w) {
                const unsigned x0 = (w < 2) ? pl[0][w & 1] : ph[0][w & 1], x1 = (w < 2) ? pl[1][w & 1] : ph[1][w & 1], x2 = (w < 2) ? pl[2][w & 1] : ph[2][w & 1], x3 = (w < 2) ? pl[3][w & 1] : ph[3][w & 1];
                *(LAS u32x2*)(KT + (8 * cg2 + 2 * w) * RT_TST + 4 * tg2) = (u32x2){pk2(bf_lo(x0) * kd[0], bf_lo(x1) * kd[1]), pk2(bf_lo(x2) * kd[2], bf_lo(x3) * kd[3])};
                *(LAS u32x2*)(KT + (8 * cg2 + 2 * w + 1) * RT_TST + 4 * tg2) = (u32x2){pk2(bf_hi(x0) * kd[0], bf_hi(x1) * kd[1]), pk2(bf_hi(x2) * kd[2], bf_hi(x3) * kd[3])};
            }
            const int qi = w8 >> 1, ki0 = 2 * (w8 & 1);
            f32x4 pa[2] = {(f32x4){0.f, 0.f, 0.f, 0.f}, (f32x4){0.f, 0.f, 0.f, 0.f}};
            {
                const LAS bf16_t* qp = Qs + (16 * qi + lr) * RT_QST + 8 * lg; const LAS bf16_t* kp0 = Ks + (16 * ki0 + lr) * RT_QST + 8 * lg; const LAS bf16_t* kp1 = kp0 + 16 * RT_QST;
                bf16x8 fa[2], fb0[2], fb1[2];
#pragma unroll
                for (int s = 0; s < 2; ++s) { fa[s] = *(const LAS bf16x8*)(qp + 32 * s); fb0[s] = *(const LAS bf16x8*)(kp0 + 32 * s); fb1[s] = *(const LAS bf16x8*)(kp1 + 32 * s); }
#pragma unroll
                for (int s = 0; s < 8; ++s) {
                    pa[0] = MFMA16(fb0[s & 1], fa[s & 1], pa[0]); pa[1] = MFMA16(fb1[s & 1], fa[s & 1], pa[1]);
                    if (s + 2 < 8) { fa[s & 1] = *(const LAS bf16x8*)(qp + 32 * (s + 2)); fb0[s & 1] = *(const LAS bf16x8*)(kp0 + 32 * (s + 2)); fb1[s & 1] = *(const LAS bf16x8*)(kp1 + 32 * (s + 2)); }
                }
            }
#pragma unroll
            for (int j = 0; j < 2; ++j) { float pv[4];
#pragma unroll
                for (int e = 0; e < 4; ++e) { const int iq = 16 * qi + lr, jk = 16 * (ki0 + j) + 4 * lg + e; const int dd = iq > jk ? iq - jk : jk - iq; pv[e] = pa[j][e] * fexp2(lg2 * (float)dd); }
                *(LAS u32x2*)(Ps + (16 * qi + lr) * RT_TST + 16 * (ki0 + j) + 4 * lg) = (u32x2){pk2(pv[0], pv[1]), pk2(pv[2], pv[3])}; }
        }
        __syncthreads();
        f32x4 ot[4];
#pragma unroll
        for (int i = 0; i < 4; ++i) ot[i] = (f32x4){0.f, 0.f, 0.f, 0.f};
        {
            const LAS bf16_t* qp = Qs + lr * RT_QST + 8 * lg;
            bf16x8 bq[2][4];
#pragma unroll
            for (int tt = 0; tt < 4; ++tt) bq[0][tt] = *(const LAS bf16x8*)(qp + 16 * tt * RT_QST);
#pragma unroll
            for (int c = 0; c < 8; ++c) {
                if (c + 1 < 8) {
#pragma unroll
                    for (int tt = 0; tt < 4; ++tt) bq[(c + 1) & 1][tt] = *(const LAS bf16x8*)(qp + 16 * tt * RT_QST + 32 * (c + 1));
                }
                u32x4 sp; sp.x = pk2(st[2 * c][0], st[2 * c][1]); sp.y = pk2(st[2 * c][2], st[2 * c][3]); sp.z = pk2(st[2 * c + 1][0], st[2 * c + 1][1]); sp.w = pk2(st[2 * c + 1][2], st[2 * c + 1][3]);
                const bf16x8 sf = __builtin_bit_cast(bf16x8, sp);
#pragma unroll
                for (int tt = 0; tt < 4; ++tt) ot[tt] = MFMA16(sf, bq[c & 1][tt], ot[tt]);
            }
        }
#pragma unroll
        for (int tt = 0; tt < 4; ++tt) ot[tt] *= fexp2(lg2 * (float)(16 * tt + lr + 1));
        bf16x8 vt[2];
#pragma unroll
        for (int s = 0; s < 2; ++s) vt[s] = *(const LAS bf16x8*)(VT + (16 * w8 + lr) * RT_TST + 32 * s + 8 * lg);
        {
            bf16x8 bp[2][4];
#pragma unroll
            for (int s = 0; s < 2; ++s)
#pragma unroll
                for (int tt = 0; tt < 4; ++tt) bp[s][tt] = *(const LAS bf16x8*)(Ps + (16 * tt + lr) * RT_TST + 32 * s + 8 * lg);
#pragma unroll
            for (int s = 0; s < 2; ++s)
#pragma unroll
                for (int tt = 0; tt < 4; ++tt) ot[tt] = MFMA16(vt[s], bp[s][tt], ot[tt]);
        }
#pragma unroll
        for (int tt = 0; tt < 4; ++tt) if (do_store) *(GAS u32x2*)(vbase + (size_t)(n * 64 + 16 * tt + lr) * RV + 16 * w8 + 4 * lg) = (u32x2){pk2(ot[tt][0], ot[tt][1]), pk2(ot[tt][2], ot[tt][3])};
        {
            const LAS bf16_t* tp = KT + lr * RT_TST + 8 * lg;
            bf16x8 ka[3][2];
#pragma unroll
            for (int k = 0; k < 2; ++k)
#pragma unroll
                for (int s = 0; s < 2; ++s) ka[k][s] = *(const LAS bf16x8*)(tp + 16 * k * RT_TST + 32 * s);
#pragma unroll
            for (int kb = 0; kb < 16; ++kb) {
                if (kb + 2 < 16) {
#pragma unroll
                    for (int s = 0; s < 2; ++s) ka[(kb + 2) % 3][s] = *(const LAS bf16x8*)(tp + 16 * (kb + 2) * RT_TST + 32 * s);
                }
                st[kb] *= g64;
                st[kb] = MFMA16(ka[kb % 3][0], vt[0], st[kb]); st[kb] = MFMA16(ka[kb % 3][1], vt[1], st[kb]);
            }
        }
        __syncthreads();
        if (more) RT_STAGE();
        __syncthreads();
    }
#undef RT_LOAD
#undef RT_STAGE
}
__device__ __forceinline__ void phase_ret(const Ctx& C0, unsigned char* ws, bool do_store) {
    const Ctx C = fresh(C0);
    const bf16_t* rq = (const bf16_t*)ACT_TM(ws, C, A_RQ, 2048); const bf16_t* rk = (const bf16_t*)ACT_TM(ws, C, A_RK, 2048); bf16_t* rv = (bf16_t*)ACT_TM(ws, C, A_RVV, RV);
#pragma unroll 1
    for (int li = rank_of(C); li < 64; li += nper_of(C)) { const int it = grp_of(C) * 64 + li; ret_unit(C, rq, rk, rv, it >> 5, (it >> 2) & 7, it & 3, do_store); }
}
__device__ __forceinline__ void phase_retnorm(const Ctx& C0, unsigned char* ws, const float* gng, const float* gnb, bool do_store = true) {
    const Ctx C = fresh(C0);
    bf16_t* rr = (bf16_t*)ACT_TM(ws, C, A_RVV, RV); const bf16_t* sg = (const bf16_t*)ACT_TM(ws, C, A_RSG, RV);
    const int gw = rank_of(C) * 8 + C.wave, NGW = nper_of(C) * 8, rbase = grp_of(C) * (4096 * 8);
    for (int lr0 = gw * 4; lr0 < 4096 * 8; lr0 += NGW * 4) { const int row0 = rbase + lr0;
        u32x4 w[4], gq[4];
#pragma unroll
        for (int k = 0; k < 4; ++k) { const size_t off = (size_t)(row0 + k) * 512 + 8 * C.lane; w[k] = __builtin_nontemporal_load((const GAS u32x4*)(rr + off)); gq[k] = __builtin_nontemporal_load((const GAS u32x4*)(sg + off)); }
#pragma unroll
        for (int k = 0; k < 4; ++k) {
            const int row = row0 + k, hd = row & 7; const size_t off = (size_t)row * 512 + 8 * C.lane;
            float x[8] = {bf_lo(w[k].x), bf_hi(w[k].x), bf_lo(w[k].y), bf_hi(w[k].y), bf_lo(w[k].z), bf_hi(w[k].z), bf_lo(w[k].w), bf_hi(w[k].w)};
            float s = 0.f;
#pragma unroll
            for (int i = 0; i < 8; ++i) s += x[i];
            const float mu = wave_sum(s) * (1.0f / 512.0f); float q = 0.f;
#pragma unroll
            for (int i = 0; i < 8; ++i) { x[i] -= mu; q += x[i] * x[i]; }
            const float rsd = rsqrtf(wave_sum(q) * (1.0f / 512.0f) + EPS);
            const int c0 = hd * 512 + 8 * C.lane;
            const f32x4 ga = *(const GAS f32x4*)(gng + c0), gb = *(const GAS f32x4*)(gng + c0 + 4), ba = *(const GAS f32x4*)(gnb + c0), bb = *(const GAS f32x4*)(gnb + c0 + 4);
            f32x4 oa, ob;
            float gg[8] = {bf_lo(gq[k].x), bf_hi(gq[k].x), bf_lo(gq[k].y), bf_hi(gq[k].y), bf_lo(gq[k].z), bf_hi(gq[k].z), bf_lo(gq[k].w), bf_hi(gq[k].w)};
#pragma unroll
            for (int i = 0; i < 8; ++i) gg[i] *= sigmoid_f(gg[i]);
            oa[0] = (x[0] * rsd * ga[0] + ba[0]) * gg[0]; oa[1] = (x[1] * rsd * ga[1] + ba[1]) * gg[1]; oa[2] = (x[2] * rsd * ga[2] + ba[2]) * gg[2]; oa[3] = (x[3] * rsd * ga[3] + ba[3]) * gg[3];
            ob[0] = (x[4] * rsd * gb[0] + bb[0]) * gg[4]; ob[1] = (x[5] * rsd * gb[1] + bb[1]) * gg[5]; ob[2] = (x[6] * rsd * gb[2] + bb[2]) * gg[6]; ob[3] = (x[7] * rsd * gb[3] + bb[3]) * gg[7];
            const u32x4 res_ = pack8(oa, ob); asm volatile("" :: "v"(res_)); if (do_store) *(GAS u32x4*)(rr + off) = res_;
        }
    }
}
__device__ __forceinline__ void phase_fixup(const Ctx& C0, unsigned char* ws, const float* cw3, const float* cb) {
    const Ctx C = fresh(C0);
    const float* side = (const float*)(ws + WS_SIDE); bf16_t* mo = (bf16_t*)ACT_TM(ws, C, A_M, FF);
    for (int li = rank_of(C) * 512 + C.tid; li < 16 * (FF / 4); li += nper_of(C) * 512) { const int i = grp_of(C) * (16 * (FF / 4)) + li;
        const int pm = i / (FF / 4), c = (i % (FF / 4)) * 4; const bool first = (pm & 7) == 0;
        f32x4 cv[2][2];
#pragma unroll
        for (int hv = 0; hv < 2; ++hv) {
            const int ch = hv * FF + c;
            const f32x4 z = {0.f, 0.f, 0.f, 0.f};
            const f32x4 am2 = first ? z : *(const GAS f32x4*)(side + ((size_t)(pm - 1) * 4 + 2) * FF2 + ch), am1 = first ? z : *(const GAS f32x4*)(side + ((size_t)(pm - 1) * 4 + 3) * FF2 + ch);
            const f32x4 a0 = *(const GAS f32x4*)(side + ((size_t)pm * 4 + 0) * FF2 + ch), a1 = *(const GAS f32x4*)(side + ((size_t)pm * 4 + 1) * FF2 + ch);
            const f32x4 w0 = *(const GAS f32x4*)(cw3 + ch), w1 = *(const GAS f32x4*)(cw3 + FF2 + ch), w2 = *(const GAS f32x4*)(cw3 + 2 * FF2 + ch), bb = *(const GAS f32x4*)(cb + ch);
            cv[hv][0] = bb + w0 * am2 + w1 * am1 + w2 * a0; cv[hv][1] = bb + w0 * am1 + w1 * a0 + w2 * a1;
        }
#pragma unroll
        for (int rw = 0; rw < 2; ++rw) { f32x4 g = cv[0][rw];
#pragma unroll
            for (int k = 0; k < 4; ++k) g[k] = gelu_t(g[k]) * cv[1][rw][k];
            *(GAS u32x2*)(mo + (size_t)(pm * 256 + rw) * FF + c) = (u32x2){pk2(g[0], g[1]), pk2(g[2], g[3])}; }
    }
}
__device__ __forceinline__ void phase_final(const Ctx& C0, float* out, const bf16_t* hb, const float* psh, const float* g) {
    const Ctx C = fresh(C0);
    const int gw = rank_of(C) * 8 + C.wave, NGW = nper_of(C) * 8;
    for (int lr = gw; lr < 4096; lr += NGW) { const int row = grp_of(C) * 4096 + lr;
        float s = C.lane < 8 ? *(const GAS float*)(psh + (size_t)row * 8 + C.lane) : 0.f; s = wave_sum(s);
        const float rsd = rsqrtf(s * (1.0f / D) + EPS); float* o = out + (size_t)row * D; const bf16_t* hr = hb + (size_t)row * D;
#pragma unroll
        for (int j = 0; j < 4; ++j) { const int c = j * 512 + 8 * C.lane; const u32x4 w = *(const GAS u32x4*)(hr + c); const f32x4 ga = *(const GAS f32x4*)(g + c), gb = *(const GAS f32x4*)(g + c + 4);
            f32x4 oa, ob; oa[0] = bf_lo(w.x); oa[1] = bf_hi(w.x); oa[2] = bf_lo(w.y); oa[3] = bf_hi(w.y); ob[0] = bf_lo(w.z); ob[1] = bf_hi(w.z); ob[2] = bf_lo(w.w); ob[3] = bf_hi(w.w);
            *(GAS f32x4*)(o + c) = oa * rsd * ga; *(GAS f32x4*)(o + c + 4) = ob * rsd * gb; }
    }
}

constexpr int NPHASE = 38;
struct Params { const void* in[27]; float* out; unsigned char* ws; int ph_lo, ph_hi; };
#define GEMM_PHASE(EPI, Aptr, Bptr, Mv, Nv, Kv, ...) do { pg8::Gemm g_{(const bf16_t*)(Aptr), (const bf16_t*)(Bptr), (Mv), (Nv), (Kv)}; pg8::StaticOrder S_; S_.init((Mv), (Nv), C.G, C.bid); \
        pg8::EPI E_{__VA_ARGS__}; pg8::gemm_phase<pg8::EPI, pg8::StaticOrder, true, true>((PG8_LAS unsigned char*)C.lds, g_, S_, E_, C.wave); } while (0)

template <class Tp> __device__ __forceinline__ Tp* opq(Tp* p) { asm volatile("" : "+s"(p)); return (Tp*)(GAS Tp*)p; }
#define SITE_VARS unsigned char* ws = opq(ws0); float* out = (float*)opq((unsigned char*)out0); unsigned char* act = ws + WS_ACT; (void)act; (void)out; \
    float* tabm = (float*)(ws + WS_TABM); float* tabr = (float*)(ws + WS_TABR); float* psq = (float*)(ws + WS_PSQ); float* pskv = (float*)(ws + WS_PSKV); float* psv = (float*)(ws + WS_PSV); (void)tabm; (void)tabr; (void)psq; (void)pskv; (void)psv; \
    bf16_t* hbc = (bf16_t*)(ws + (cur ? WS_HB1 : WS_HB0)); bf16_t* hbn = (bf16_t*)(ws + (cur ? WS_HB0 : WS_HB1)); float* psc = (float*)(ws + (cur ? WS_PSH1 : WS_PSH0)); float* psn = (float*)(ws + (cur ? WS_PSH0 : WS_PSH1)); (void)hbc; (void)hbn; (void)psc; (void)psn;
__global__ void __launch_bounds__(512, 2) fwd(Params P) {
    extern __shared__ __attribute__((aligned(16))) unsigned char lds_raw[];
    Ctx C; C.lds = (LAS unsigned char*)lds_raw; C.tid = threadIdx.x; C.lane = C.tid & 63; C.wave = __builtin_amdgcn_readfirstlane(C.tid >> 6); C.G = gridDim.x; C.bid = blockIdx.x;
    { const int t0_ = C.tid; C.tid = 0; C.lane = 0; if (t0_ < 64) ((volatile LAS unsigned*)(C.lds + LDS_MISC))[t0_] = 0u; }
    volatile LAS unsigned* misc = (volatile LAS unsigned*)(C.lds + LDS_MISC);
    __syncthreads();
    unsigned char* const ws0 = P.ws; float* const out0 = P.out;
    XcdBarrier bar; bar.bar = (unsigned*)(ws0 + WS_CTL) + CW_BAR; bar.x = 0; bar.st = misc;
#if MK_ONE_LAUNCH
    bar = xcd_barrier_post((unsigned*)(ws0 + WS_CTL) + CW_BAR, misc);
#endif
    const int lo = P.ph_lo, hi = P.ph_hi;
#ifndef SITE_ONLY
#define SITE_ONLY -1
#endif
#define SITE(n) (SITE_ONLY < 0 || SITE_ONLY == (n))
#define IN(k) (lo <= (k) && (k) < hi)
#define SEAM(k) do { if (IN(k) && IN((k) + 1)) xcd_barrier(bar); } while (0)
#define SEAM_L(k) do { if (IN(k) && IN((k) + 1)) { if (__builtin_amdgcn_readfirstlane((int)misc[3]) != 0) xcd_local_barrier(bar); else xcd_barrier(bar); } } while (0)
#define AP(OFF, W) ACT_TM(ws, C, OFF, W)

    enum { EV_D4 = 0, EV_D5, EV_D6, EV_D7, EV_D8, EV_RA, EV_RBC, EV_RDE };
#define LM() (__builtin_amdgcn_readfirstlane((int)misc[3]) != 0)
#define SEAM_S(k, s1, s2, rel) do { if (IN(k) && IN((k) + 1)) { if (LM()) xcd_local_barrier(bar, (s1), (s2), (rel)); else xcd_barrier(bar); } } while (0)
#define EV_WAIT(k, ev, tgt, acq) do { if (IN((k) - 1) && IN(k) && LM()) xcd_event_wait(bar, (ev), (unsigned)(tgt), (acq)); } while (0)
    int cur = 0;
    if constexpr (SITE(0)) if (IN(0)) { SITE_VARS
        phase_init(C, (const float*)(const GAS float*)P.in[0], (const int*)(const GAS int*)P.in[2], tabm, tabr, (bf16_t*)(ws + WS_HB0), (float*)(ws + WS_PSH0)); }
    if constexpr (SITE(1)) if (IN(1)) { SITE_VARS phase_prep(C, P.in, ws, 0, PREP_ALL, false); }
    SEAM(1);
#if MK_ONE_LAUNCH
    if (IN(1) && IN(2)) {
        if (LM()) C.bid = __builtin_amdgcn_readfirstlane((int)(misc[2] * 8u + bar.x));
    }
#endif
#pragma unroll 1
    for (int L = 0; L < DEPTH; ++L) {
        const int pb = 1 + 9 * L, j = L >> 1; const bool nxt = L + 1 < DEPTH;
        if (L >= 1) EV_WAIT(pb + 1, EV_RA, 8 * L, true);
        if ((L & 1) == 0) {
            if constexpr (SITE(2)) if (IN(pb + 1)) { SITE_VARS GEMM_PHASE(EpiE1, hbc, ws + WS_WMIX + WM_EIN, T, EINP, D, psc, (bf16_t*)AP(A_CQ, QL), (bf16_t*)AP(A_CKV, KVL), (bf16_t*)AP(A_KROT, 64), (bf16_t*)AP(A_UG, 1024), (bf16_t*)AP(A_VG, 1024), psq, pskv, psv, tabm, (PG8_LAS float*)(C.lds + LDS_XCH + 12288)); }
            SEAM_L(pb + 1);
            if constexpr (SITE(3)) if (IN(pb + 2)) { SITE_VARS
                GEMM_PHASE(EpiE2, AP(A_CQ, QL), ws + WS_WMIX + WM_QUP, T, QUPN, QL, psq, (bf16_t*)AP(A_Q, QUPN), tabm, (PG8_LAS float*)(C.lds + LDS_XCH + 12288));
                GEMM_PHASE(EpiE3k, AP(A_CKV, KVL), ws + WS_WMIX + WM_KVK, T, 1024, KVL, pskv, (bf16_t*)AP(A_KN, 1024), (PG8_LAS float*)(C.lds + LDS_XCH + 12288));
                GEMM_PHASE(EpiE3v, ws + WS_WMIX + WM_KVV, AP(A_CKV, KVL), 1024, T, KVL, pskv, (bf16_t*)ACT_VT(ws, C));
            }
            SEAM_L(pb + 2);
        } else {
            if constexpr (SITE(6)) if (IN(pb + 1)) { SITE_VARS GEMM_PHASE(EpiO1, hbc, ws + WS_WMIX + WM_RIN, T, RIN, D, psc, (bf16_t*)AP(A_RQ, 2048), (bf16_t*)AP(A_RK, 2048), (bf16_t*)AP(A_RVV, RV), (bf16_t*)AP(A_RSG, RV), tabr, (PG8_LAS float*)(C.lds + LDS_XCH + 12288)); }
            SEAM_L(pb + 1);
            if constexpr (SITE(7)) if (IN(pb + 2)) { SITE_VARS phase_ret(C, ws, true); }
            SEAM_L(pb + 2);
        }
        if (L >= 1) {
            EV_WAIT(pb + 3, EV_D7, 8 * L, false); EV_WAIT(pb + 3, EV_D8, 8 * L, false);
            if constexpr (SITE(1)) if (IN(pb + 3)) { SITE_VARS phase_prep(C, P.in, ws, L, PREP_FDN | PREP_PLEG, true); }
        }
        if ((L & 1) == 0) {
            if constexpr (SITE(4)) if (IN(pb + 3)) { SITE_VARS
                phase_attn(C, ws);
                phase_sgu(C, ws, (const float*)(const GAS float*)P.in[9] + (size_t)j * 1024, (const float*)(const GAS float*)P.in[10] + (size_t)j * 1024, (const float*)(const GAS float*)P.in[12] + (size_t)j * 1024);
            }
            SEAM_S(pb + 3, L >= 1 ? (int)EV_RDE : -1, -1, L >= 1);
            if constexpr (SITE(5)) if (IN(pb + 4)) { SITE_VARS GEMM_PHASE(EpiResid, AP(A_AB, D), ws + WS_WMIX + WM_EOUT, T, D, D, hbc, hbc, psc, (PG8_LAS float*)(C.lds + LDS_XCH)); }
        } else {
            if constexpr (SITE(8)) if (IN(pb + 3)) { SITE_VARS phase_retnorm(C, ws, (const float*)(const GAS float*)P.in[15] + (size_t)j * RV, (const float*)(const GAS float*)P.in[16] + (size_t)j * RV); }
            SEAM_S(pb + 3, L >= 1 ? (int)EV_RDE : -1, -1, L >= 1);
            if constexpr (SITE(9)) if (IN(pb + 4)) { SITE_VARS GEMM_PHASE(EpiResid, AP(A_RVV, RV), ws + WS_WMIX + WM_ROUT, T, D, RV, hbc, hbc, psc, (PG8_LAS float*)(C.lds + LDS_XCH)); }
        }
        SEAM_S(pb + 4, EV_D4, -1, false);
        if (L >= 1) EV_WAIT(pb + 5, EV_RBC, 8 * L, true);
        if constexpr (SITE(10)) if (IN(pb + 5)) { SITE_VARS
            GEMM_PHASE(EpiF1, hbc, ws + WS_WFFN + WF_UP, T, FF2, D, psc, (bf16_t*)AP(A_M, FF), (float*)(ws + WS_SIDE), (const float*)(const GAS float*)P.in[20] + (size_t)L * 3 * FF2, (const float*)(const GAS float*)P.in[21] + (size_t)L * FF2, (PG8_LAS float*)(C.lds + LDS_XCH)); }
        SEAM_S(pb + 5, EV_D5, -1, false);
        if (nxt) {
            EV_WAIT(pb + 6, EV_D4, 8 * (L + 1), false);
            if constexpr (SITE(1)) if (IN(pb + 6)) { SITE_VARS phase_prep(C, P.in, ws, L + 1, PREP_MIX, true); }
        }
        if constexpr (SITE(11)) if (IN(pb + 6)) { SITE_VARS
            phase_fixup(C, ws, (const float*)(const GAS float*)P.in[20] + (size_t)L * 3 * FF2, (const float*)(const GAS float*)P.in[21] + (size_t)L * FF2);
            GEMM_PHASE(EpiStore, ws + WS_PBF, ws + WS_WPLE + WP_U, T, D, PLE, (bf16_t*)AP(A_UPV, D), D);
        }
        SEAM_S(pb + 6, EV_D6, nxt ? (int)EV_RA : -1, nxt);
        if (L >= 1) EV_WAIT(pb + 7, EV_RDE, 8 * L, true);
        if constexpr (SITE(12)) if (IN(pb + 7)) { SITE_VARS GEMM_PHASE(EpiResid, AP(A_M, FF), ws + WS_WFFN + WF_DN, T, D, FF, hbc, hbc, psc, (PG8_LAS float*)(C.lds + LDS_XCH)); }
        SEAM_S(pb + 7, EV_D7, -1, false);
        if (nxt) {
            EV_WAIT(pb + 8, EV_D5, 8 * (L + 1), false); EV_WAIT(pb + 8, EV_D6, 8 * (L + 1), false);
            if constexpr (SITE(1)) if (IN(pb + 8)) { SITE_VARS phase_prep(C, P.in, ws, L + 1, PREP_FUP | PREP_PLEU, true); }
        }
        if constexpr (SITE(13)) if (IN(pb + 8)) { SITE_VARS GEMM_PHASE(EpiPle, hbc, ws + WS_WPLE + WP_G, T, D, D, hbc, (const bf16_t*)AP(A_UPV, D), hbn, psc, psn, (PG8_LAS float*)(C.lds + LDS_XCH), (PG8_LAS float*)(C.lds + LDS_XCH + 12288)); }
        SEAM_S(pb + 8, EV_D8, nxt ? (int)EV_RBC : -1, nxt);
        cur ^= 1;
    }
    if constexpr (SITE(14)) if (IN(NPHASE - 1)) { SITE_VARS phase_final(C, out, hbc, psc, (const float*)(const GAS float*)P.in[26]); }
#undef LM
#undef SEAM_S
#undef EV_WAIT
#undef IN
#undef SEAM
#undef SEAM_L
#undef AP
}

extern "C" void kernel_launch(void* const* d_in, const int* in_sizes, int n_in, void* d_out, int out_size, void* d_ws, size_t ws_size, hipStream_t stream) {
    static int grid = 0;
    if (grid == 0) {
        if (n_in != 27 || out_size != T * D || ws_size < WS_END) { fprintf(stderr, "kernel_launch: unexpected problem (n_in %d, out %d, ws %zu < %zu)\n", n_in, out_size, ws_size, (size_t)WS_END); grid = -1; return; }
        int dev = 0, cus = 0, per_cu = 0;
        if (hipGetDevice(&dev) != hipSuccess || hipDeviceGetAttribute(&cus, hipDeviceAttributeMultiprocessorCount, dev) != hipSuccess) { grid = -1; return; }
        if (hipFuncSetAttribute((const void*)fwd, hipFuncAttributeMaxDynamicSharedMemorySize, LDS_BYTES) != hipSuccess) { fprintf(stderr, "kernel_launch: hipFuncSetAttribute failed\n"); grid = -1; return; }
        if (hipOccupancyMaxActiveBlocksPerMultiprocessor(&per_cu, (const void*)fwd, 512, LDS_BYTES) != hipSuccess || per_cu < 1) fprintf(stderr, "kernel_launch: occupancy query says %d\n", per_cu);
        (void)hipGetLastError();
        grid = cus >= 8 ? cus - cus % 8 : 256;
    }
    if (grid < 0) return;
    if (hipMemsetAsync((char*)d_ws + WS_CTL, 0, CTL_ZERO_BYTES, stream) != hipSuccess) return;
    Params p{};
    for (int i = 0; i < 27; ++i) p.in[i] = d_in[i];
    p.out = (float*)d_out; p.ws = (unsigned char*)d_ws;
#if MK_ONE_LAUNCH
    p.ph_lo = 0; p.ph_hi = NPHASE;
    hipLaunchKernelGGL(fwd, dim3(grid), dim3(512), LDS_BYTES, stream, p);
#else
    for (int k = 0; k < NPHASE; ++k) { p.ph_lo = k; p.ph_hi = k + 1; hipLaunchKernelGGL(fwd, dim3(grid), dim3(512), LDS_BYTES, stream, p); }
#endif
    const hipError_t le = hipPeekAtLastError();
    if (le != hipSuccess) fprintf(stderr, "kernel_launch: launch failed: %s\n", hipGetErrorName(le));
}
```
